# Optimizing an MI355X kernel written in HIP

```python
import math
import jax, jax.numpy as jnp
from jax import lax
import numpy as np

D_MODEL = 1024
BATCH = 32
SEQ = 2048
DEPTH = 2
DEC_BATCH = 1
DEC_SEQ = 16384
PAST_LEN = 128

HEAD_DIM = 64
N_Q_HEADS = 12
N_KV_HEADS_A = 4
N_MEM_HEADS = 4
MEM_LEN = 256
WINDOW = 128
BLOCK = 128
GRID_W = 64
NA_ROWS_MAX = 8
NA_COLS = 16
D_FF = 2816
CONV_W = 3
EPS = 1e-6
NEG = -1e30
N_LAYERS_A = (DEPTH + 1) // 2
N_LAYERS_B = DEPTH // 2
Q_WIDTH = N_Q_HEADS * HEAD_DIM
KV_WIDTH_A = N_KV_HEADS_A * HEAD_DIM
MEM_WIDTH = N_MEM_HEADS * HEAD_DIM
IN_WIDTH_A = Q_WIDTH + 2 * KV_WIDTH_A + MEM_WIDTH
IN_WIDTH_B = 3 * Q_WIDTH + MEM_WIDTH
MIX_WIDTH = Q_WIDTH + MEM_WIDTH
RPB_ROWS = 2 * NA_ROWS_MAX - 1
RPB_COLS = 2 * NA_COLS - 1

kernel_name = "hybrid_window_gqa_natten_memory_convffn_encoder"


def rms_norm(x, g):
    xf = x.astype(jnp.float32)
    y = xf * lax.rsqrt(jnp.mean(xf * xf, axis=-1, keepdims=True) + EPS)
    return (y * g.astype(jnp.float32)).astype(x.dtype)


def alibi_slopes(n):
    return jnp.asarray((2.0 ** (-8.0 * np.arange(1, n + 1, dtype=np.float32) / n)).astype(np.float32))


def window_gqa(q, k, v, sink):
    B, T, Hq, d = q.shape
    Hkv = k.shape[2]
    rep = Hq // Hkv
    nb = T // BLOCK
    kb_len = BLOCK + 2 * WINDOW
    kp = jnp.pad(k, ((0, 0), (WINDOW, WINDOW), (0, 0), (0, 0)))
    vp = jnp.pad(v, ((0, 0), (WINDOW, WINDOW), (0, 0), (0, 0)))
    qg = q.reshape(B, T, Hkv, rep, d)
    rel = jnp.arange(BLOCK)[:, None] - jnp.arange(kb_len)[None, :] + WINDOW
    in_window = jnp.abs(rel) <= WINDOW
    alibi = -alibi_slopes(Hq).reshape(Hkv, rep, 1, 1) * jnp.abs(rel).astype(jnp.float32)
    sink_f = sink.astype(jnp.float32).reshape(Hkv, rep, 1)
    scale = HEAD_DIM ** -0.5

    def one_block(j):
        start = j * BLOCK
        qb = lax.dynamic_slice_in_dim(qg, start, BLOCK, axis=1).astype(jnp.float32)
        kb = lax.dynamic_slice_in_dim(kp, start, kb_len, axis=1).astype(jnp.float32)
        vb = lax.dynamic_slice_in_dim(vp, start, kb_len, axis=1).astype(jnp.float32)
        s_pos = start - WINDOW + jnp.arange(kb_len)
        valid = in_window & ((s_pos >= 0) & (s_pos < T))[None, :]
        sc = jnp.einsum('bqgrd,bkgd->bgrqk', qb, kb) * scale + alibi
        sc = jnp.where(valid, sc, NEG)
        m = jnp.maximum(sc.max(axis=-1), sink_f)
        p = jnp.exp(sc - m[..., None])
        denom = p.sum(axis=-1) + jnp.exp(sink_f - m)
        o = jnp.einsum('bgrqk,bkgd->bqgrd', p, vb)
        o = o / jnp.transpose(denom, (0, 3, 1, 2))[..., None]
        return o.astype(q.dtype)

    out = lax.map(one_block, jnp.arange(nb))
    return jnp.moveaxis(out, 0, 1).reshape(B, T, Hq * d)


def neighbourhood_attn(q, k, v, rpb):
    B, T, H, d = q.shape
    rows = T // GRID_W
    kr = min(NA_ROWS_MAX, rows)
    qg = q.reshape(B, rows, GRID_W, H, d)
    kg = k.reshape(B, rows, GRID_W, H, d)
    vg = v.reshape(B, rows, GRID_W, H, d)
    cols = np.arange(GRID_W)
    c0 = np.clip(cols - NA_COLS // 2, 0, GRID_W - NA_COLS)
    col_idx = c0[:, None] + np.arange(NA_COLS)[None, :]
    dc = col_idx - cols[:, None]
    bias_cols = rpb.astype(jnp.float32)[:, :, dc + NA_COLS - 1]
    scale = HEAD_DIM ** -0.5

    def one_row(r):
        r0 = jnp.clip(r - kr // 2, 0, rows - kr)
        qr = lax.dynamic_index_in_dim(qg, r, axis=1, keepdims=False).astype(jnp.float32)
        kw = lax.dynamic_slice_in_dim(kg, r0, kr, axis=1)
        vw = lax.dynamic_slice_in_dim(vg, r0, kr, axis=1)
        kq = kw[:, :, col_idx].astype(jnp.float32)
        vq = vw[:, :, col_idx].astype(jnp.float32)
        dr = r0 + jnp.arange(kr) - r + NA_ROWS_MAX - 1
        bias = jnp.transpose(bias_cols[:, dr], (0, 2, 1, 3))
        sc = jnp.einsum('bchd,bicjhd->bhcij', qr, kq) * scale + bias[None]
        p = jax.nn.softmax(sc.reshape(B, H, GRID_W, kr * NA_COLS), axis=-1)
        p = p.reshape(B, H, GRID_W, kr, NA_COLS)
        o = jnp.einsum('bhcij,bicjhd->bchd', p, vq)
        return o.astype(q.dtype)

    out = lax.map(one_row, jnp.arange(rows))
    return jnp.moveaxis(out, 0, 1).reshape(B, T, H * d)


def memory_attn(qm, mem_n, w_mem_kv):
    B, T, Hm, d = qm.shape
    kv = mem_n @ w_mem_kv
    km, vm = jnp.split(kv, 2, axis=-1)
    km = km.reshape(B, -1, Hm, d).astype(jnp.float32)
    vm = vm.reshape(B, -1, Hm, d).astype(jnp.float32)
    sc = jnp.einsum('bthd,bmhd->bhtm', qm.astype(jnp.float32), km) * (HEAD_DIM ** -0.5)
    p = jax.nn.softmax(sc, axis=-1)
    o = jnp.einsum('bhtm,bmhd->bthd', p, vm)
    return o.reshape(B, T, Hm * d).astype(qm.dtype)


def conv_ffn(h, w_gate, w_up, conv_w, conv_b, w_down):
    T = h.shape[1]
    g = h @ w_gate
    pad = CONV_W // 2
    gp = jnp.pad(g, ((0, 0), (pad, pad), (0, 0)))
    g = sum(gp[:, tap:tap + T] * conv_w[tap] for tap in range(CONV_W)) + conv_b
    return (jax.nn.silu(g) * (h @ w_up)) @ w_down


def trunk(x, mem, g_mix, g_mem, w_in_a, sink_a, w_in_b, rpb_b, w_mem_kv, w_o,
          g_ffn, w_gate, w_up, conv_w, conv_b, w_down, g_final):
    B, T, _ = x.shape
    for i in range(DEPTH):
        h = rms_norm(x, g_mix[i])
        mem_n = rms_norm(mem, g_mem[i])
        j = i // 2
        if i % 2 == 0:
            proj = h @ w_in_a[j]
            q, k, v, qm = jnp.split(proj, [Q_WIDTH, Q_WIDTH + KV_WIDTH_A, Q_WIDTH + 2 * KV_WIDTH_A], axis=-1)
            o_mix = window_gqa(q.reshape(B, T, N_Q_HEADS, HEAD_DIM),
                               k.reshape(B, T, N_KV_HEADS_A, HEAD_DIM),
                               v.reshape(B, T, N_KV_HEADS_A, HEAD_DIM), sink_a[j])
        else:
            proj = h @ w_in_b[j]
            q, k, v, qm = jnp.split(proj, [Q_WIDTH, 2 * Q_WIDTH, 3 * Q_WIDTH], axis=-1)
            o_mix = neighbourhood_attn(q.reshape(B, T, N_Q_HEADS, HEAD_DIM),
                                       k.reshape(B, T, N_Q_HEADS, HEAD_DIM),
                                       v.reshape(B, T, N_Q_HEADS, HEAD_DIM), rpb_b[j])
        o_mem = memory_attn(qm.reshape(B, T, N_MEM_HEADS, HEAD_DIM), mem_n, w_mem_kv[i])
        x = x + jnp.concatenate([o_mix, o_mem], axis=-1) @ w_o[i]
        h = rms_norm(x, g_ffn[i])
        x = x + conv_ffn(h, w_gate[i], w_up[i], conv_w[i], conv_b[i], w_down[i])
    return rms_norm(x, g_final)


def setup_inputs(seed: int = 0) -> dict:
    key = jax.random.key(seed)
    ks = jax.random.split(key, 20)
    f32 = jnp.float32

    def nrm(k, shape, scale):
        return jax.random.normal(k, shape, f32) * scale

    return {
        "x_prompt": nrm(ks[0], (BATCH, SEQ, D_MODEL), 1.0),
        "x_sample": nrm(ks[1], (DEC_BATCH, DEC_SEQ, D_MODEL), 1.0),
        "mem_prompt": nrm(ks[2], (BATCH, MEM_LEN, D_MODEL), 1.0),
        "mem_sample": nrm(ks[3], (DEC_BATCH, MEM_LEN, D_MODEL), 1.0),
        "g_mix": 1.0 + nrm(ks[4], (DEPTH, D_MODEL), 0.02),
        "g_mem": 1.0 + nrm(ks[5], (DEPTH, D_MODEL), 0.02),
        "w_in_a": nrm(ks[6], (N_LAYERS_A, D_MODEL, IN_WIDTH_A), D_MODEL ** -0.5),
        "sink_a": nrm(ks[7], (N_LAYERS_A, N_Q_HEADS), 0.5),
        "w_in_b": nrm(ks[8], (N_LAYERS_B, D_MODEL, IN_WIDTH_B), D_MODEL ** -0.5),
        "rpb_b": nrm(ks[9], (N_LAYERS_B, N_Q_HEADS, RPB_ROWS, RPB_COLS), 0.1),
        "w_mem_kv": nrm(ks[10], (DEPTH, D_MODEL, 2 * MEM_WIDTH), D_MODEL ** -0.5),
        "w_o": nrm(ks[11], (DEPTH, MIX_WIDTH, D_MODEL), MIX_WIDTH ** -0.5),
        "g_ffn": 1.0 + nrm(ks[12], (DEPTH, D_MODEL), 0.02),
        "w_gate": nrm(ks[13], (DEPTH, D_MODEL, D_FF), D_MODEL ** -0.5),
        "w_up": nrm(ks[14], (DEPTH, D_MODEL, D_FF), D_MODEL ** -0.5),
        "conv_w": nrm(ks[15], (DEPTH, CONV_W, D_FF), CONV_W ** -0.5),
        "conv_b": nrm(ks[16], (DEPTH, D_FF), 0.01),
        "w_down": nrm(ks[17], (DEPTH, D_FF, D_MODEL), D_FF ** -0.5),
        "g_final": 1.0 + nrm(ks[18], (D_MODEL,), 0.02),
    }


def reference(x_prompt, x_sample, mem_prompt, mem_sample, g_mix, g_mem, w_in_a, sink_a, w_in_b, rpb_b,
              w_mem_kv, w_o, g_ffn, w_gate, w_up, conv_w, conv_b, w_down, g_final):
    y_prompt = trunk(x_prompt, mem_prompt, g_mix, g_mem, w_in_a, sink_a, w_in_b, rpb_b, w_mem_kv, w_o,
                     g_ffn, w_gate, w_up, conv_w, conv_b, w_down, g_final)
    y_sample = trunk(x_sample, mem_sample, g_mix, g_mem, w_in_a, sink_a, w_in_b, rpb_b, w_mem_kv, w_o,
                     g_ffn, w_gate, w_up, conv_w, conv_b, w_down, g_final)
    return (y_prompt, y_sample)
```

```cpp
#include <hip/hip_runtime.h>
#include <hip/hip_cooperative_groups.h>
#include <cstdio>
#include <cstdint>
namespace cg = cooperative_groups;

#ifndef PROBE_REP
#define PROBE_REP 0
#endif
#define NREP(k) (((PROBE_REP >> (k)) & 1) ? 2 : 1)
#ifndef MK_ONE_LAUNCH
#define MK_ONE_LAUNCH 1
#endif

namespace pg8 {
#define PG8_LAS __attribute__((address_space(3)))
typedef unsigned short bf16_t;
typedef short bf16x8 __attribute__((ext_vector_type(8)));
typedef float f32x4 __attribute__((ext_vector_type(4)));
typedef unsigned u32x4 __attribute__((ext_vector_type(4)));
typedef unsigned u32x2 __attribute__((ext_vector_type(2)));
constexpr int BM = 256, BK = 64, HALF = 128, HTB = HALF * BK * 2, STAGE_BYTES = 8 * HTB, NXCD = 8, WGM = 8;

__host__ __device__ __forceinline__ int lds_byte(int r, int c) { const int st = (r >> 4) * 2 + (c >> 5), rr = r & 15, cc = c & 31, ob = rr * 64 + cc * 2; return st * 1024 + (ob ^ (((ob >> 9) & 1) << 5)); }
__host__ __device__ __forceinline__ void stage_rc(int b, int& R, int& C) { const int st = b / 1024, sb = b % 1024, swz = sb ^ (((sb >> 9) & 1) << 5); R = (st >> 1) * 16 + swz / 64; C = (st & 1) * 32 + (swz % 64) / 2; }
__host__ __device__ __forceinline__ int perm32(int rho) { const int n = rho >> 4, i = rho & 15; return 8 * (i >> 2) + 4 * n + (i & 3); }

__host__ __device__ __forceinline__ size_t ilv_off(int r, int k, int K) { return (size_t)(r >> 4) * (16 * (size_t)K) + (size_t)(r & 7) * (2 * (size_t)K) + (size_t)(k >> 5) * 64 + (size_t)((r >> 3) & 1) * 32 + (k & 31); }
struct Unit { int pm, pn; };
struct Gemm { const bf16_t* A; const bf16_t* Bt; int M, N, K, ailv; };

struct StaticOrder {
    int nM, nN, nwg, G, c;
    __host__ __device__ void init(int M, int N, int G_, int c_) { nM = M / BM; nN = N / BM; nwg = nM * nN; G = G_; c = c_; }
    __host__ __device__ bool next(int i, Unit& u) const {
        const long L = (long)i * G + c; if (L >= nwg) return false;
        int wgid = (int)L; { const int q = nwg / NXCD, r = nwg % NXCD, xcd = wgid % NXCD, off = wgid / NXCD; wgid = (xcd < r ? xcd * (q + 1) : r * (q + 1) + (xcd - r) * q) + off; }
        const int nig = WGM * nN, gid = wgid / nig, fm = gid * WGM, gsz = (nM - fm) < WGM ? (nM - fm) : WGM;
        u.pm = fm + ((wgid % nig) % gsz); u.pn = (wgid % nig) / gsz; return true;
    }
};

__device__ __forceinline__ unsigned cvt_pk_bf16(float lo, float hi) { unsigned r; asm volatile("v_cvt_pk_bf16_f32 %0, %1, %2" : "=v"(r) : "v"(lo), "v"(hi)); return r; }
__device__ __forceinline__ float rstd_of(const float* ss, int row) { const f32x4 p = *(const f32x4*)(ss + (size_t)row * 4); return __builtin_amdgcn_rsqf(((p[0] + p[1]) + (p[2] + p[3])) * (1.0f / 1024.0f) + 1e-6f); }


__device__ __forceinline__ u32x4 xchg8(const u32x4 v) {
    u32x4 r;
#pragma unroll
    for (int i = 0; i < 4; ++i) r[i] = (unsigned)__builtin_amdgcn_update_dpp(0, (int)v[i], 0x128, 0xf, 0xf, true);
    return r;
}
__device__ __forceinline__ u32x4 sel4(bool c, const u32x4 a, const u32x4 b) { u32x4 r; r.x = c ? a.x : b.x; r.y = c ? a.y : b.y; r.z = c ? a.z : b.z; r.w = c ? a.w : b.w; return r; }

struct EpiScaleBf16 {
    static constexpr bool PERM = true;
    bf16_t* O; int ldc; const float* ss;
    __device__ __forceinline__ void operator()(f32x4 (&acc)[2][2][4][2], const Unit& u, int wr, int wc, int fr, int fq) const {
        asm volatile("" : "+v"(fr), "+v"(fq)); asm volatile("" : "+s"(wr), "+s"(wc));
        const bool lo = fr < 8;
        const int row0 = u.pm * BM + wr * 64 + fr, col0 = u.pn * BM + wc * 64 + 8 * fq;
        bf16_t* base = O + (size_t)(u.pm * BM + wr * 64 + (fr & 7)) * ldc + col0 + (lo ? 0 : 32);
#pragma unroll
        for (int ai = 0; ai < 2; ++ai)
#pragma unroll
            for (int m = 0; m < 4; ++m) {
                const float rs = rstd_of(ss, row0 + ai * HALF + m * 16);
                u32x4 w[2];
#pragma unroll
                for (int bj = 0; bj < 2; ++bj) { const f32x4 v0 = acc[ai][bj][m][0] * rs, v1 = acc[ai][bj][m][1] * rs;
                    w[bj].x = cvt_pk_bf16(v0[0], v0[1]); w[bj].y = cvt_pk_bf16(v0[2], v0[3]); w[bj].z = cvt_pk_bf16(v1[0], v1[1]); w[bj].w = cvt_pk_bf16(v1[2], v1[3]); }
                const u32x4 y = xchg8(sel4(lo, w[1], w[0]));
                bf16_t* rp = base + (size_t)(ai * HALF + m * 16) * ldc;
                *(u32x4*)rp = sel4(lo, w[0], y);
                *(u32x4*)(rp + (size_t)8 * ldc) = sel4(lo, y, w[1]);
            }
    }
};

__device__ __forceinline__ f32x4 bf_lo4(unsigned w0, unsigned w1) { return (f32x4){__builtin_bit_cast(float, w0 << 16), __builtin_bit_cast(float, w0 & 0xffff0000u), __builtin_bit_cast(float, w1 << 16), __builtin_bit_cast(float, w1 & 0xffff0000u)}; }
struct EpiResid {
    static constexpr bool PERM = true;
    bf16_t* xb; float* ss; PG8_LAS float* red;
    __device__ __forceinline__ void operator()(f32x4 (&acc)[2][2][4][2], const Unit& u, int wr, int wc, int fr, int fq) const {
        asm volatile("" : "+v"(fr), "+v"(fq)); asm volatile("" : "+s"(wr), "+s"(wc));
        const bool lo = fr < 8;
        const int col0 = u.pn * BM + wc * 64 + 8 * fq;
        bf16_t* base = xb + (size_t)(u.pm * BM + wr * 64 + (fr & 7)) * 1024 + col0 + (lo ? 0 : 32);
#pragma unroll
        for (int ai = 0; ai < 2; ++ai)
#pragma unroll
            for (int m = 0; m < 4; ++m) {
                const int rl = ai * HALF + wr * 64 + m * 16 + fr;
                bf16_t* rp = base + (size_t)(ai * HALF + m * 16) * 1024;
                const u32x4 la = *(const u32x4*)rp, lb = *(const u32x4*)(rp + (size_t)8 * 1024);
                const u32x4 yi = xchg8(sel4(lo, lb, la));
                u32x4 xo[2]; xo[0] = sel4(lo, la, yi); xo[1] = sel4(lo, yi, lb);
                float sq = 0.f; u32x4 w[2];
#pragma unroll
                for (int bj = 0; bj < 2; ++bj) {
                    const f32x4 v0 = acc[ai][bj][m][0] + bf_lo4(xo[bj].x, xo[bj].y), v1 = acc[ai][bj][m][1] + bf_lo4(xo[bj].z, xo[bj].w);
                    sq += (v0[0] * v0[0] + v0[1] * v0[1]) + (v0[2] * v0[2] + v0[3] * v0[3]) + (v1[0] * v1[0] + v1[1] * v1[1]) + (v1[2] * v1[2] + v1[3] * v1[3]);
                    w[bj].x = cvt_pk_bf16(v0[0], v0[1]); w[bj].y = cvt_pk_bf16(v0[2], v0[3]); w[bj].z = cvt_pk_bf16(v1[0], v1[1]); w[bj].w = cvt_pk_bf16(v1[2], v1[3]);
                }
                const u32x4 yo = xchg8(sel4(lo, w[1], w[0]));
                *(u32x4*)rp = sel4(lo, w[0], yo); *(u32x4*)(rp + (size_t)8 * 1024) = sel4(lo, yo, w[1]);
                sq += __shfl_xor(sq, 16); sq += __shfl_xor(sq, 32);
                if (fq == 0) red[rl * 4 + wc] = sq;
            }
        asm volatile("s_waitcnt lgkmcnt(0)" ::: "memory"); __builtin_amdgcn_s_barrier(); asm volatile("" ::: "memory");
        const int tid = threadIdx.x;
        if (tid < 256) { const f32x4 p = *(const PG8_LAS f32x4*)(red + tid * 4); ss[(size_t)(u.pm * BM + tid) * 4 + u.pn] = (p[0] + p[1]) + (p[2] + p[3]); }
    }
};

struct EpiFinal {
    static constexpr bool PERM = true;
    const bf16_t* xb; float* xout; const float* gfin; float* xs; unsigned* cnt; PG8_LAS float* red;
    __device__ __forceinline__ void operator()(f32x4 (&acc)[2][2][4][2], const Unit& u, int wr, int wc, int fr, int fq) const {
        asm volatile("" : "+v"(fr), "+v"(fq)); asm volatile("" : "+s"(wr), "+s"(wc));
        const int col0 = u.pn * BM + wc * 64 + 8 * fq;
#pragma unroll
        for (int ai = 0; ai < 2; ++ai)
#pragma unroll
            for (int m = 0; m < 4; ++m) {
                const int rl = ai * HALF + wr * 64 + m * 16 + fr, row = u.pm * BM + rl;
                const bf16_t* xi = xb + (size_t)row * 1024 + col0;
                float sq = 0.f;
#pragma unroll
                for (int bj = 0; bj < 2; ++bj) {
                    const u32x4 xo = *(const u32x4*)(xi + bj * 32);
                    const f32x4 v0 = acc[ai][bj][m][0] + bf_lo4(xo.x, xo.y), v1 = acc[ai][bj][m][1] + bf_lo4(xo.z, xo.w);
                    sq += (v0[0] * v0[0] + v0[1] * v0[1]) + (v0[2] * v0[2] + v0[3] * v0[3]) + (v1[0] * v1[0] + v1[1] * v1[1]) + (v1[2] * v1[2] + v1[3] * v1[3]);
                    acc[ai][bj][m][0] = v0; acc[ai][bj][m][1] = v1;
                }
                sq += __shfl_xor(sq, 16); sq += __shfl_xor(sq, 32);
                if (fq == 0) red[rl * 4 + wc] = sq;
            }
        asm volatile("s_waitcnt lgkmcnt(0)" ::: "memory"); __builtin_amdgcn_s_barrier(); asm volatile("" ::: "memory");
        const int tid = threadIdx.x;
        unsigned* cw_ = cnt + 64 * u.pm;
        if (tid < 256) {
            const f32x4 p = *(const PG8_LAS f32x4*)(red + tid * 4);
            __hip_atomic_store(xs + (size_t)(u.pm * 4 + u.pn) * 256 + tid, (p[0] + p[1]) + (p[2] + p[3]), __ATOMIC_RELAXED, __HIP_MEMORY_SCOPE_AGENT);
            asm volatile("s_waitcnt vmcnt(0)" ::: "memory");
            if ((tid & 63) == 0) __hip_atomic_fetch_add(cw_, 1u, __ATOMIC_RELAXED, __HIP_MEMORY_SCOPE_AGENT);
        }
        if (tid < 64) {
            unsigned sp = 0u;
            while ((unsigned)__builtin_amdgcn_readfirstlane(__hip_atomic_load(cw_, __ATOMIC_RELAXED, __HIP_MEMORY_SCOPE_AGENT)) < 16u) { __builtin_amdgcn_s_sleep(2); if (++sp > (1u << 24)) break; }
            __builtin_amdgcn_fence(__ATOMIC_ACQUIRE, "agent");
        }
        asm volatile("s_waitcnt vmcnt(0) lgkmcnt(0)" ::: "memory"); __builtin_amdgcn_s_barrier(); asm volatile("" ::: "memory");
        if (tid < 256) {
            const float* xp = xs + (size_t)(u.pm * 4) * 256 + tid;
            const float t0 = __hip_atomic_load(xp, __ATOMIC_RELAXED, __HIP_MEMORY_SCOPE_AGENT), t1 = __hip_atomic_load(xp + 256, __ATOMIC_RELAXED, __HIP_MEMORY_SCOPE_AGENT),
                        t2 = __hip_atomic_load(xp + 512, __ATOMIC_RELAXED, __HIP_MEMORY_SCOPE_AGENT), t3 = __hip_atomic_load(xp + 768, __ATOMIC_RELAXED, __HIP_MEMORY_SCOPE_AGENT);
            red[1024 + tid] = __builtin_amdgcn_rsqf(((t0 + t1) + (t2 + t3)) * (1.0f / 1024.0f) + 1e-6f);
        }
        asm volatile("s_waitcnt lgkmcnt(0)" ::: "memory"); __builtin_amdgcn_s_barrier(); asm volatile("" ::: "memory");
        f32x4 gv[2][2];
#pragma unroll
        for (int bj = 0; bj < 2; ++bj) { gv[bj][0] = *(const f32x4*)(gfin + col0 + bj * 32); gv[bj][1] = *(const f32x4*)(gfin + col0 + bj * 32 + 4); }
#pragma unroll
        for (int ai = 0; ai < 2; ++ai)
#pragma unroll
            for (int m = 0; m < 4; ++m) {
                const int rl = ai * HALF + wr * 64 + m * 16 + fr, row = u.pm * BM + rl;
                const float rs = red[1024 + rl];
                float* xo = xout + (size_t)row * 1024 + col0;
#pragma unroll
                for (int bj = 0; bj < 2; ++bj) { *(f32x4*)(xo + bj * 32) = acc[ai][bj][m][0] * rs * gv[bj][0]; *(f32x4*)(xo + bj * 32 + 4) = acc[ai][bj][m][1] * rs * gv[bj][1]; }
            }
    }
};

struct EpiGateUp {
    static constexpr bool PERM = true;
    bf16_t* act; const float* ss; const float* cw; const float* cb; float* sb; PG8_LAS float* edge;
    __device__ __forceinline__ void operator()(f32x4 (&acc)[2][2][4][2], const Unit& u, int wr, int wc, int fr, int fq) const {
        asm volatile("" : "+v"(fr), "+v"(fq)); asm volatile("" : "+s"(wr), "+s"(wc));
        const int slot0 = wc * 32 + 8 * fq, fcol0 = u.pn * 128 + slot0;
#pragma unroll
        for (int ai = 0; ai < 2; ++ai)
#pragma unroll
            for (int m = 0; m < 4; ++m) {
                const float rs = rstd_of(ss, u.pm * BM + ai * HALF + wr * 64 + m * 16 + fr);
#pragma unroll
                for (int bj = 0; bj < 2; ++bj)
#pragma unroll
                    for (int n = 0; n < 2; ++n) acc[ai][bj][m][n] = acc[ai][bj][m][n] * rs;
            }
        PG8_LAS float* eB = edge + slot0, * eT = edge + 17 * 128 + slot0;
        if (fr == 0 || fr == 15) {
            PG8_LAS float* e0 = (fr == 15 ? eB + 128 : eT) + wr * 4 * 128;
#pragma unroll
            for (int ai = 0; ai < 2; ++ai)
#pragma unroll
                for (int m = 0; m < 4; ++m) { *(PG8_LAS f32x4*)(e0 + (ai * 8 + m) * 128) = acc[ai][0][m][0]; *(PG8_LAS f32x4*)(e0 + (ai * 8 + m) * 128 + 4) = acc[ai][0][m][1]; }
        }
        asm volatile("s_waitcnt lgkmcnt(0)" ::: "memory"); __builtin_amdgcn_s_barrier(); asm volatile("" ::: "memory");
        const PG8_LAS float* rB = eB + wr * 4 * 128, * rT = eT + (wr * 4 + 1) * 128;
        const int rowb = u.pm * BM + wr * 64 + fr;
        u32x2 keep[2][4];
#pragma unroll
        for (int n = 0; n < 2; ++n) {
            const f32x4 w0 = *(const f32x4*)(cw + fcol0 + 4 * n), w1 = *(const f32x4*)(cw + 2816 + fcol0 + 4 * n), w2 = *(const f32x4*)(cw + 5632 + fcol0 + 4 * n), bb = *(const f32x4*)(cb + fcol0 + 4 * n);
#pragma unroll
            for (int ai = 0; ai < 2; ++ai)
#pragma unroll
                for (int m = 0; m < 4; ++m) {
                    const f32x4 ep = *(const PG8_LAS f32x4*)(rB + (ai * 8 + m) * 128 + 4 * n), en = *(const PG8_LAS f32x4*)(rT + (ai * 8 + m) * 128 + 4 * n);
                    f32x4 cv, av;
#pragma unroll
                    for (int e = 0; e < 4; ++e) {
                        const float g = acc[ai][0][m][n][e];
                        const float up = __builtin_bit_cast(float, __builtin_amdgcn_update_dpp(0, __builtin_bit_cast(int, g), 0x111, 0xf, 0xf, true));
                        const float dn = __builtin_bit_cast(float, __builtin_amdgcn_update_dpp(0, __builtin_bit_cast(int, g), 0x101, 0xf, 0xf, true));
                        const float prev = (fr == 0) ? ep[e] : up, next = (fr == 15) ? en[e] : dn;
                        const float c = w0[e] * prev + w1[e] * g + w2[e] * next + bb[e];
                        const float sg = __builtin_amdgcn_rcpf(1.0f + __builtin_amdgcn_exp2f(-1.4426950408889634f * c));
                        cv[e] = c; av[e] = c * sg * acc[ai][1][m][n][e];
                    }
                    const bool seam = (ai == 0 && m == 0) ? (wr == 0 && fr == 0) : ((ai == 1 && m == 3) ? (wr == 1 && fr == 15) : false);
                    if (seam) {
                        float* s = sb + (size_t)((u.pm * 2 + ai) * 3) * 2816 + fcol0 + 4 * n;
                        *(f32x4*)(s) = acc[ai][0][m][n]; *(f32x4*)(s + 2816) = cv; *(f32x4*)(s + 5632) = acc[ai][1][m][n];
                    }
                    {
                        u32x2 w; w.x = cvt_pk_bf16(av[0], av[1]); w.y = cvt_pk_bf16(av[2], av[3]);
                        if (n == 0) keep[ai][m] = w;
                        else if (!seam) { u32x4 w4; w4.x = keep[ai][m].x; w4.y = keep[ai][m].y; w4.z = w.x; w4.w = w.y; *(u32x4*)(act + ilv_off(rowb + ai * HALF + m * 16, fcol0, 2816)) = w4; }
                    }
                }
        }
    }
};

template <class Epi, class Sched, bool ALIGN_EPI = true, bool SP2 = true>
__device__ __forceinline__ void gemm_phase(PG8_LAS unsigned char* lds, const Gemm g, const Sched& S, const Epi& E) {
    int tid = threadIdx.x; asm volatile("" : "+v"(tid));
    const int wid = __builtin_amdgcn_readfirstlane(tid >> 6), lane = tid & 63, wr = wid >> 2, wc = wid & 3, fr = lane & 15, fq = lane >> 4;
    const int K = g.K, nt = K / BK;
    unsigned voffA[2], voffB[2];
#pragma unroll
    for (int i = 0; i < 2; ++i) { int R, C; stage_rc(tid * 16 + i * 8192, R, C); const int Rb = Epi::PERM ? (64 * (R >> 5) + perm32(R & 31)) : R;
        voffA[i] = g.ailv ? (unsigned)ilv_off(R, C, K) * 2u : (unsigned)(R * K + C) * 2u; voffB[i] = (unsigned)(Rb * K + C) * 2u; }
    const size_t kstep = (size_t)(BK * 2), kstepA = g.ailv ? 2 * kstep : kstep;
    const size_t hstepA = (size_t)HALF * K * 2, hstepB = (size_t)32 * K * 2;
    const size_t tstep = 2 * hstepA;
    const unsigned ldsw = (unsigned)wid * 1024u;
    const int aoff = lds_byte(wr * 64 + fr, fq * 8), boff = lds_byte(wc * 32 + fr, fq * 8);
#define PG8_SA(b, h) (((b) * 2 + (h)) * HTB)
#define PG8_SB(b, h) ((4 + (b) * 2 + (h)) * HTB)
#define PG8_STAGE(bufoff, gbase, voff) do { _Pragma("unroll") for (int _i = 0; _i < 2; ++_i) \
        __builtin_amdgcn_global_load_lds((const unsigned*)((const char*)(gbase) + (voff)[_i]), (PG8_LAS unsigned*)(lds + (bufoff) + ldsw + _i * 8192), 16, 0, 0); } while (0)
#define PG8_LDA(dst, b, h) do { _Pragma("unroll") for (int m = 0; m < 4; ++m) _Pragma("unroll") for (int k = 0; k < 2; ++k) dst[m][k] = *(const PG8_LAS bf16x8*)(lds + PG8_SA(b, h) + aoff + m * 2048 + k * 1024); } while (0)
#define PG8_LDB(dst, b, h) do { _Pragma("unroll") for (int n = 0; n < 2; ++n) _Pragma("unroll") for (int k = 0; k < 2; ++k) dst[n][k] = *(const PG8_LAS bf16x8*)(lds + PG8_SB(b, h) + boff + n * 2048 + k * 1024); } while (0)
#define PG8_MMA(ai, bj, At, Bt) do { __builtin_amdgcn_s_setprio(1); _Pragma("unroll") for (int m = 0; m < 4; ++m) _Pragma("unroll") for (int n = 0; n < 2; ++n) _Pragma("unroll") for (int k = 0; k < 2; ++k) \
        acc[ai][bj][m][n] = __builtin_amdgcn_mfma_f32_16x16x32_bf16(Bt[n][k], At[m][k], acc[ai][bj][m][n], 0, 0, 0); __builtin_amdgcn_s_setprio(0); } while (0)
#define PG8_WAIT_V(n) asm volatile("s_waitcnt vmcnt(" #n ")" ::: "memory")
#define PG8_WAIT_L(n) asm volatile("s_waitcnt lgkmcnt(" #n ")" ::: "memory")
#define PG8_BAR __builtin_amdgcn_s_barrier()
#define PG8_SCHED __builtin_amdgcn_sched_barrier(0)
    Unit cur, nxt; int ui = 0;
    if (!S.next(0, cur)) return;
    f32x4 acc[2][2][4][2];
#pragma unroll
    for (int a = 0; a < 2; ++a)
#pragma unroll
        for (int b = 0; b < 2; ++b)
#pragma unroll
            for (int m = 0; m < 4; ++m)
#pragma unroll
                for (int n = 0; n < 2; ++n) acc[a][b][m][n] = (f32x4){0.f, 0.f, 0.f, 0.f};
    bf16x8 At[4][2], B0[2][2], B1[2][2];
    const char* cA = (const char*)g.A + (size_t)cur.pm * tstep; const char* cB = (const char*)g.Bt + (size_t)cur.pn * tstep;
    if constexpr (SP2) {
        PG8_STAGE(PG8_SB(0, 0), cB, voffB); PG8_STAGE(PG8_SB(0, 1), cB + hstepB, voffB); PG8_STAGE(PG8_SA(0, 0), cA, voffA); PG8_STAGE(PG8_SA(0, 1), cA + hstepA, voffA);
        if (wr == 1) PG8_BAR;
        PG8_WAIT_V(2); PG8_BAR;
        PG8_STAGE(PG8_SB(1, 0), cB + kstep, voffB); PG8_STAGE(PG8_SA(1, 0), cA + kstepA, voffA); PG8_STAGE(PG8_SB(1, 1), cB + hstepB + kstep, voffB);
        PG8_WAIT_V(6); PG8_BAR;
    } else {
        PG8_STAGE(PG8_SB(0, 0), cB, voffB); PG8_STAGE(PG8_SA(0, 0), cA, voffA); PG8_STAGE(PG8_SB(0, 1), cB + hstepB, voffB); PG8_STAGE(PG8_SA(0, 1), cA + hstepA, voffA);
        if (wr == 1) PG8_BAR;
        PG8_WAIT_V(4); PG8_BAR;
        PG8_STAGE(PG8_SB(1, 0), cB + kstep, voffB); PG8_STAGE(PG8_SA(1, 0), cA + kstepA, voffA); PG8_STAGE(PG8_SB(1, 1), cB + hstepB + kstep, voffB);
        PG8_WAIT_V(6); PG8_BAR;
    }
    for (;;) {
        const bool has_next = S.next(ui + 1, nxt);
        const char* nA = has_next ? (const char*)g.A + (size_t)nxt.pm * tstep : cA; const char* nB = has_next ? (const char*)g.Bt + (size_t)nxt.pn * tstep : cB;
        for (int t = 0; t < nt; t += 2) {
            const bool last = (t == nt - 2);
            const char* a1 = cA + (size_t)(t + 1) * kstepA;
            const char* a2 = last ? nA : cA + (size_t)(t + 2) * kstepA; const char* b2 = last ? nB : cB + (size_t)(t + 2) * kstep;
            const char* a3 = a2 + kstepA; const char* b3 = b2 + kstep;
            if constexpr (SP2) {
            PG8_LDB(B0, 0, 0); PG8_LDB(B1, 0, 1); PG8_SCHED; PG8_LDA(At, 0, 0); PG8_STAGE(PG8_SA(1, 1), a1 + hstepA, voffA);
            PG8_WAIT_V(8); PG8_WAIT_L(0); PG8_BAR; PG8_MMA(0, 0, At, B0); PG8_MMA(0, 1, At, B1); PG8_BAR; PG8_SCHED;
            PG8_LDA(At, 0, 1); PG8_STAGE(PG8_SB(0, 0), b2, voffB); PG8_STAGE(PG8_SB(0, 1), b2 + hstepB, voffB); PG8_STAGE(PG8_SA(0, 0), a2, voffA);
            PG8_WAIT_V(8); PG8_WAIT_L(0); PG8_BAR; PG8_MMA(1, 0, At, B0); PG8_MMA(1, 1, At, B1); PG8_BAR; PG8_SCHED;
            PG8_LDB(B0, 1, 0); PG8_LDB(B1, 1, 1); PG8_SCHED; PG8_LDA(At, 1, 0); PG8_STAGE(PG8_SA(0, 1), a2 + hstepA, voffA);
            PG8_WAIT_V(8); PG8_WAIT_L(0); PG8_BAR; PG8_MMA(0, 0, At, B0); PG8_MMA(0, 1, At, B1); PG8_BAR; PG8_SCHED;
            PG8_LDA(At, 1, 1); PG8_STAGE(PG8_SB(1, 0), b3, voffB); PG8_STAGE(PG8_SB(1, 1), b3 + hstepB, voffB); PG8_STAGE(PG8_SA(1, 0), a3, voffA);
            PG8_WAIT_V(8); PG8_WAIT_L(0); PG8_BAR; PG8_MMA(1, 0, At, B0); PG8_MMA(1, 1, At, B1); PG8_BAR; PG8_SCHED;
            } else {
            PG8_LDB(B0, 0, 0); PG8_SCHED; PG8_LDA(At, 0, 0); PG8_STAGE(PG8_SA(1, 1), a1 + hstepA, voffA);
            PG8_WAIT_L(8); PG8_BAR; PG8_WAIT_L(0); PG8_MMA(0, 0, At, B0); PG8_BAR; PG8_SCHED;
            PG8_LDB(B1, 0, 1); PG8_STAGE(PG8_SB(0, 0), b2, voffB);
            PG8_BAR; PG8_WAIT_L(0); PG8_MMA(0, 1, At, B1); PG8_BAR;
            PG8_LDA(At, 0, 1); PG8_STAGE(PG8_SA(0, 0), a2, voffA);
            PG8_BAR; PG8_WAIT_L(0); PG8_MMA(1, 0, At, B0); PG8_BAR; PG8_SCHED;
            PG8_STAGE(PG8_SB(0, 1), b2 + hstepB, voffB);
            PG8_WAIT_V(6); PG8_BAR; PG8_MMA(1, 1, At, B1); PG8_BAR;
            PG8_LDB(B0, 1, 0); PG8_SCHED; PG8_LDA(At, 1, 0); PG8_STAGE(PG8_SA(0, 1), a2 + hstepA, voffA);
            PG8_WAIT_L(8); PG8_BAR; PG8_WAIT_L(0); PG8_MMA(0, 0, At, B0); PG8_BAR; PG8_SCHED;
            PG8_LDB(B1, 1, 1); PG8_STAGE(PG8_SB(1, 0), b3, voffB);
            PG8_BAR; PG8_WAIT_L(0); PG8_MMA(0, 1, At, B1); PG8_BAR;
            PG8_LDA(At, 1, 1); PG8_STAGE(PG8_SA(1, 0), a3, voffA);
            PG8_BAR; PG8_WAIT_L(0); PG8_MMA(1, 0, At, B0); PG8_BAR; PG8_SCHED;
            PG8_STAGE(PG8_SB(1, 1), b3 + hstepB, voffB);
            PG8_WAIT_V(6); PG8_BAR; PG8_MMA(1, 1, At, B1); PG8_BAR;
            }
        }
        if constexpr (ALIGN_EPI) { if (wr == 0) PG8_BAR; }
        E(acc, cur, wr, wc, fr, fq);
        if (!has_next) break;
#pragma unroll
        for (int a = 0; a < 2; ++a)
#pragma unroll
            for (int b = 0; b < 2; ++b)
#pragma unroll
                for (int m = 0; m < 4; ++m)
#pragma unroll
                    for (int n = 0; n < 2; ++n) acc[a][b][m][n] = (f32x4){0.f, 0.f, 0.f, 0.f};
        cur = nxt; cA = nA; cB = nB; ++ui;
        if constexpr (ALIGN_EPI) { if (wr == 1) PG8_BAR; }
    }
    PG8_WAIT_V(0);
    if constexpr (!ALIGN_EPI) { if (wr == 0) PG8_BAR; }
    PG8_BAR;
#undef PG8_SA
#undef PG8_SB
#undef PG8_STAGE
#undef PG8_LDA
#undef PG8_LDB
#undef PG8_MMA
#undef PG8_WAIT_V
#undef PG8_WAIT_L
#undef PG8_BAR
#undef PG8_SCHED
}
}

#define LAS __attribute__((address_space(3)))
#define CAS __attribute__((address_space(4)))
typedef unsigned short bf16;
typedef float f32x4 __attribute__((ext_vector_type(4)));
typedef float f32x16 __attribute__((ext_vector_type(16)));
typedef short bf16x8 __attribute__((ext_vector_type(8)));
typedef short s16x4 __attribute__((ext_vector_type(4)));
typedef unsigned u32x4 __attribute__((ext_vector_type(4)));
typedef unsigned u32x2 __attribute__((ext_vector_type(2)));

constexpr int D = 1024, MTOK = 81920, MPROMPT = 65536, MMEM = 8448, FF = 2816;
constexpr int NTILE = MTOK / 256;
constexpr size_t MiB = 1u << 20;
constexpr size_t WS_CTL = 0, CTL_ZERO_BYTES = 131072;
constexpr int CW_PANEL = 4096;
constexpr size_t WS_XS = 110 * MiB + 768 * 1024;
constexpr size_t WS_WINA = 1 * MiB, WS_WINB = 4 * MiB, WS_WMKV = 9 * MiB, WS_WO = 11 * MiB, WS_WGU = 15 * MiB, WS_WD = 37 * MiB;
constexpr size_t WS_SS = 49 * MiB, WS_SSM = 55 * MiB, WS_MB = 56 * MiB, WS_MKV = 73 * MiB, WS_SB = 90 * MiB;
constexpr size_t WS_XB = 112 * MiB, WS_PROJ = 272 * MiB, WS_O = 672 * MiB, WS_ACT = 272 * MiB, WS_END = 832 * MiB;
static_assert(WS_WINA + (size_t)1536 * 1024 * 2 <= WS_WINB && WS_WINB + (size_t)2560 * 1024 * 2 <= WS_WMKV && WS_WMKV + (size_t)1024 * 1024 * 2 <= WS_WO && WS_WO + (size_t)2 * 1024 * 1024 * 2 <= WS_WGU &&
              WS_WGU + (size_t)2 * 5632 * 1024 * 2 <= WS_WD && WS_WD + (size_t)2 * 1024 * 2816 * 2 <= WS_SS && WS_SS + (size_t)MTOK * 16 <= WS_SSM && WS_SSM + (size_t)MMEM * 16 <= WS_MB &&
              WS_MB + (size_t)MMEM * 1024 * 2 <= WS_MKV && WS_MKV + (size_t)MMEM * 1024 * 2 <= WS_SB && WS_SB + (size_t)NTILE * 6 * FF * 4 <= WS_XB && WS_XB + (size_t)MTOK * 1024 * 2 <= WS_PROJ &&
              WS_PROJ + (size_t)MTOK * 2560 * 2 <= WS_O && WS_O + (size_t)MTOK * 1024 * 2 <= WS_END && WS_ACT + (size_t)MTOK * FF * 2 <= WS_END, "d_ws map");

static_assert((CW_PANEL + 64 * 320) * 4 <= (int)CTL_ZERO_BYTES && WS_SB + (size_t)NTILE * 6 * FF * 4 <= WS_XS && WS_XS + (size_t)320 * 4 * 256 * 4 <= WS_XB, "ctl / exchange map");
constexpr int LDS_X_OFF = 131072;
constexpr int MISC_OFF = 131072 + 2 * 17 * 128 * 4 + 512;
constexpr int LDS_BYTES = 131072 + 2 * 17 * 128 * 4 + 1024;
constexpr int NWAVES = 8;

__device__ __forceinline__ unsigned f2bf(float f) { unsigned u = __builtin_bit_cast(unsigned, f); return (u + 0x7fffu + ((u >> 16) & 1u)) >> 16; }
__device__ __forceinline__ unsigned pk2(float lo, float hi) { return f2bf(lo) | (f2bf(hi) << 16); }
__device__ __forceinline__ float wave_sum(float v) {
#pragma unroll
    for (int o = 1; o < 64; o <<= 1) v += __shfl_xor(v, o);
    return v;
}

#define XB_TMO      128
#define XB_XCNT(j)  (256  + 64 * (j))
#define XB_XSUB(j)  (1280 + 64 * (j))
#define XB_XGEN(j)  (2304 + 64 * (j))
#define XB_TOP      3328
#define XB_TOPGEN   3392
#define XCD_BAR_WORDS 3456
#define XB_SPIN_CAP (1u << 22)
__device__ __forceinline__ unsigned xb_ld(unsigned* p)              { return __hip_atomic_load(p, __ATOMIC_RELAXED, __HIP_MEMORY_SCOPE_AGENT); }
__device__ __forceinline__ unsigned xb_add(unsigned* p, unsigned v) { return __hip_atomic_fetch_add(p, v, __ATOMIC_RELAXED, __HIP_MEMORY_SCOPE_AGENT); }
__device__ __forceinline__ unsigned xb_xcc_id() { return (unsigned)__builtin_amdgcn_s_getreg((3 << 11) | 20) & 0xFu; }
#define XB_SPIN(cond, bar) do { unsigned _sp = 0; while (cond) { __builtin_amdgcn_s_sleep(1); \
    if ((++_sp & 255u) == 0u) { if (xb_ld(&(bar)[XB_TMO])) break; if (_sp > XB_SPIN_CAP) { atomicAdd(&(bar)[XB_TMO], 1u); break; } } } } while (0)
__device__ __forceinline__ void xcd_barrier_complete(unsigned* bar, unsigned x, unsigned& nloc, unsigned& nx) {
    const unsigned G = gridDim.x * gridDim.y * gridDim.z;
    unsigned sum, cnt, mine, sp = 0u;
    for (;;) {
        sum = 0u; cnt = 0u; mine = 0u;
#pragma unroll
        for (unsigned j = 0; j < 16; ++j) { const unsigned c = xb_ld(&bar[XB_XCNT(j)]); sum += c; cnt += (c > 0u) ? 1u : 0u; mine = (j == x) ? c : mine; }
        if (sum == G) break;
        __builtin_amdgcn_s_sleep(1);
        if ((++sp & 255u) == 0u) { if (xb_ld(&bar[XB_TMO])) break; if (sp > XB_SPIN_CAP) { atomicAdd(&bar[XB_TMO], 1u); break; } }
    }
    nloc = mine > 0u ? mine : 1u; nx = cnt > 0u ? cnt : 1u;
}
__device__ __forceinline__ void xcd_barrier(unsigned* bar, volatile __attribute__((address_space(3))) unsigned* st) {
    asm volatile("s_waitcnt vmcnt(0)" ::: "memory");
    __syncthreads();
    if (threadIdx.x == 0) {
        const unsigned x = xb_xcc_id();
        __builtin_amdgcn_s_waitcnt(0);
        unsigned nloc = st[0], nx = st[1];
        if (nloc == 0u) { xcd_barrier_complete(bar, x, nloc, nx); st[0] = nloc; st[1] = nx; }
        const unsigned old = xb_add(&bar[XB_XSUB(x)], 1u);
        const unsigned gen = old / nloc;
        if (old + 1u == (gen + 1u) * nloc) {
            __builtin_amdgcn_fence(__ATOMIC_RELEASE, "agent");
            asm volatile("s_waitcnt vmcnt(0)" ::: "memory");
            const unsigned og = xb_add(&bar[XB_TOP], 1u);
            const unsigned tg = og / nx;
            if (og + 1u == (tg + 1u) * nx) xb_add(&bar[XB_TOPGEN], 1u);
            else XB_SPIN(xb_ld(&bar[XB_TOPGEN]) == tg, bar);
            __builtin_amdgcn_fence(__ATOMIC_ACQUIRE, "agent");
            xb_add(&bar[XB_XGEN(x)], 1u);
            asm volatile("s_waitcnt vmcnt(0)" ::: "memory");
        } else {
            XB_SPIN(xb_ld(&bar[XB_XGEN(x)]) == gen, bar);
            __builtin_amdgcn_fence(__ATOMIC_ACQUIRE, "agent");
            asm volatile("s_waitcnt vmcnt(0)" ::: "memory");
        }
    }
    __syncthreads();
}

__device__ __forceinline__ void p0_transpose_item(const float* W, int K, int N, bf16* WT, int row_off, int mode, const float* gain, LAS float* scr, int item, int lane) {
    const int nblk = N / 32, kb = item / nblk, nb = item % nblk, k0 = 64 * kb, n0 = 32 * nb;
#pragma unroll 8
    for (int i = 0; i < 32; ++i) { const int kk = 2 * i + (lane >> 5); float v = W[(size_t)(k0 + kk) * N + n0 + (lane & 31)]; if (gain) v *= gain[k0 + kk]; scr[kk * 33 + (lane & 31)] = v; }
    asm volatile("s_waitcnt lgkmcnt(0)" ::: "memory");
    const int c = lane & 7;
    const int drow0 = (mode == 0) ? row_off + n0 : (n0 / 128) * 256 + ((n0 % 128) / 32) * 64 + (mode - 1) * 32;
#pragma unroll
    for (int j = 0; j < 4; ++j) { const int n = (lane >> 3) + 8 * j; const LAS float* s = scr + (8 * c) * 33 + n;
        u32x4 o; o.x = pk2(s[0 * 33], s[1 * 33]); o.y = pk2(s[2 * 33], s[3 * 33]); o.z = pk2(s[4 * 33], s[5 * 33]); o.w = pk2(s[6 * 33], s[7 * 33]);
        *(u32x4*)(WT + (size_t)(drow0 + n) * K + k0 + 8 * c) = o; }
    asm volatile("s_waitcnt lgkmcnt(0)" ::: "memory");
}
__device__ __forceinline__ void row_to_bf16(const float* xrow, bf16* orow, float* ssrow, int lane) {
    const f32x4* xr = (const f32x4*)xrow + lane;
    f32x4 v[4]; float s = 0.f;
#pragma unroll
    for (int j = 0; j < 4; ++j) { v[j] = xr[64 * j]; s += (v[j].x * v[j].x + v[j].y * v[j].y) + (v[j].z * v[j].z + v[j].w * v[j].w); }
    s = wave_sum(s);
    u32x2* o8 = (u32x2*)orow + lane;
#pragma unroll
    for (int j = 0; j < 4; ++j) { u32x2 w; w.x = pk2(v[j].x, v[j].y); w.y = pk2(v[j].z, v[j].w); o8[64 * j] = w; }
    if (lane == 0) *(f32x4*)ssrow = (f32x4){s, 0.f, 0.f, 0.f};
}

struct Args {
    const float* in[19]; float* out; unsigned char* ws; int ph_lo, ph_hi;
};

constexpr float LOG2E = 1.4426950408889634f;
constexpr float CSC = 0.125f * LOG2E;
#define MFMA32(a, b, c) __builtin_amdgcn_mfma_f32_32x32x16_bf16((a), (b), (c), 0, 0, 0)
__device__ __forceinline__ int crow(int i, int hi) { return (i & 3) + 8 * (i >> 2) + 4 * hi; }

template <int UN> struct VRegs { u32x4 a[UN], b[UN]; };
template <int UN> __device__ __forceinline__ void vt_load(VRegs<UN>& R, const bf16* Vbase, int pitch, int gk0, int kl_lo, int kl_hi) {
    const int npair = (kl_hi - kl_lo) >> 1, total = npair * 8;
#pragma unroll
    for (int uu = 0; uu < UN; ++uu) {
        const int idx = threadIdx.x + uu * NWAVES * 64;
        if (idx < total) {
            const int c = idx / npair, p = idx - c * npair, kl = kl_lo + 2 * p;
            const bf16* src = Vbase + (size_t)(gk0 + kl) * pitch + 8 * c;
            R.a[uu] = *(const u32x4*)src; R.b[uu] = *(const u32x4*)(src + pitch);
        }
    }
}
template <int UN> __device__ __forceinline__ void vt_store(const VRegs<UN>& R, LAS unsigned char* vt, int VS, int kl_lo, int kl_hi) {
    const int npair = (kl_hi - kl_lo) >> 1, total = npair * 8, rs = VS / 2;
#pragma unroll
    for (int uu = 0; uu < UN; ++uu) {
        const int idx = threadIdx.x + uu * NWAVES * 64;
        if (idx < total) {
            const int c = idx / npair, p = idx - c * npair, kl = kl_lo + 2 * p;
            LAS unsigned* dst = (LAS unsigned*)(vt + ((size_t)(8 * c) * VS + kl) * 2);
#pragma unroll
            for (int i = 0; i < 4; ++i) {
                dst[(2 * i) * rs] = (R.a[uu][i] & 0xffffu) | (R.b[uu][i] << 16);
                dst[(2 * i + 1) * rs] = (R.a[uu][i] >> 16) | (R.b[uu][i] & 0xffff0000u);
            }
        }
    }
}
template <int UN> struct KRegs { u32x4 a[UN]; };
template <int UN> __device__ __forceinline__ void kt_load(KRegs<UN>& R, const bf16* Kbase, int pitch, int gk0, int kl_lo, int kl_hi) {
    const int total = (kl_hi - kl_lo) * 8;
#pragma unroll
    for (int uu = 0; uu < UN; ++uu) {
        const int idx = threadIdx.x + uu * NWAVES * 64;
        if (idx < total) { const int kl = kl_lo + (idx >> 3), c = idx & 7; R.a[uu] = *(const u32x4*)(Kbase + (size_t)(gk0 + kl) * pitch + 8 * c); }
    }
}
template <int UN> __device__ __forceinline__ void kt_store(const KRegs<UN>& R, LAS unsigned char* kt, int kl_lo, int kl_hi) {
    const int total = (kl_hi - kl_lo) * 8;
#pragma unroll
    for (int uu = 0; uu < UN; ++uu) {
        const int idx = threadIdx.x + uu * NWAVES * 64;
        if (idx < total) { const int kl = kl_lo + (idx >> 3), c = idx & 7; *(LAS u32x4*)(kt + kl * 128 + ((c ^ ((kl >> 1) & 7)) << 4)) = R.a[uu]; }
    }
}
__device__ __forceinline__ void load_kfrag_lds(bf16x8 (&f)[4], const LAS unsigned char* kt, int kl  , int hi) {
    const LAS unsigned char* p = kt + kl * 128; const int sw = (kl >> 1) & 7;
#pragma unroll
    for (int ks = 0; ks < 4; ++ks) f[ks] = *(const LAS bf16x8*)(p + (((2 * ks + hi) ^ sw) << 4));
}
__device__ __forceinline__ void load_frag4(bf16x8 (&f)[4], const bf16* p) {
#pragma unroll
    for (int ks = 0; ks < 4; ++ks) f[ks] = *(const bf16x8*)(p + 16 * ks);
}
__device__ __forceinline__ void attn_step(f32x16& s, float& m, float& l, f32x16 (&o)[2], const LAS unsigned char* vt, int VSb, int kb0, int lane) {
    float mxa = fmaxf(fmaxf(s[0], s[1]), s[2]), mxb = fmaxf(fmaxf(s[3], s[4]), s[5]);
    mxa = fmaxf(fmaxf(mxa, s[6]), s[7]); mxb = fmaxf(fmaxf(mxb, s[8]), s[9]); mxa = fmaxf(fmaxf(mxa, s[10]), s[11]); mxb = fmaxf(fmaxf(mxb, s[12]), s[13]); mxa = fmaxf(fmaxf(mxa, s[14]), s[15]);
    float mx = fmaxf(mxa, mxb);
    mx = fmaxf(mx, __shfl_xor(mx, 32));
    if (__any(mx > m + 8.0f)) {
        const float mn = fmaxf(m, mx);
        const float corr = __builtin_amdgcn_exp2f(m - mn);
        m = mn; l = l * corr;
#pragma unroll
        for (int d = 0; d < 2; ++d) o[d] = o[d] * corr;
    }
    float sum = 0.f;
#pragma unroll
    for (int i = 0; i < 16; ++i) { s[i] = __builtin_amdgcn_exp2f(s[i] - m); sum += s[i]; }
    sum += __shfl_xor(sum, 32);
    l = l + sum;
    bf16x8 pb[2];
#pragma unroll
    for (int st = 0; st < 2; ++st) {
        u32x4 w; w.x = pg8::cvt_pk_bf16(s[8 * st + 0], s[8 * st + 1]); w.y = pg8::cvt_pk_bf16(s[8 * st + 2], s[8 * st + 3]); w.z = pg8::cvt_pk_bf16(s[8 * st + 4], s[8 * st + 5]); w.w = pg8::cvt_pk_bf16(s[8 * st + 6], s[8 * st + 7]);
        pb[st] = __builtin_bit_cast(bf16x8, w);
    }
    const int dl = lane & 31, hi = lane >> 5;
#pragma unroll
    for (int db = 0; db < 2; ++db)
#pragma unroll
        for (int st = 0; st < 2; ++st) {
            const LAS unsigned char* p = vt + (size_t)(32 * db + dl) * VSb + (size_t)(kb0 + 16 * st + 4 * hi) * 2;
            const s16x4 a0 = *(const LAS s16x4*)p, a1 = *(const LAS s16x4*)(p + 16);
            const bf16x8 a = __builtin_shufflevector(a0, a1, 0, 1, 2, 3, 4, 5, 6, 7);
            o[db] = MFMA32(a, pb[st], o[db]);
        }
}
__device__ __forceinline__ void store_o(const f32x16 (&o)[2], float l, bf16* orow, int hi) {
    const float inv = 1.0f / l;
#pragma unroll
    for (int db = 0; db < 2; ++db)
#pragma unroll
        for (int ig = 0; ig < 4; ++ig) {
            u32x2 w; w.x = pg8::cvt_pk_bf16(o[db][4 * ig] * inv, o[db][4 * ig + 1] * inv); w.y = pg8::cvt_pk_bf16(o[db][4 * ig + 2] * inv, o[db][4 * ig + 3] * inv);
            *(u32x2*)(orow + 32 * db + 8 * ig + 4 * hi) = w;
        }
}
__device__ __forceinline__ void tile_seq(int pm, int& seq, int& jb, int& T, int& seqbase) {
    if (pm < 256) { seq = pm >> 3; jb = pm & 7; T = 2048; seqbase = seq * 2048; } else { seq = 32; jb = pm - 256; T = 16384; seqbase = MPROMPT; }
}

__device__ __forceinline__ void window_chunk(const LAS unsigned char* vt, int VSb, const LAS unsigned char* kt, const bf16x8 (&qf)[4], bf16* O, int seqbase, int T, int jb, int g, int r, int qc, float sink, int lane) {
    const int q = lane & 31, hi = lane >> 5, hq = 3 * g + r, t0 = 256 * jb + 32 * qc, t = t0 + q;
    const float slope2 = exp2f(-8.0f * (float)(hq + 1) / 12.0f) * LOG2E;
    float m = sink * LOG2E, l = 1.0f;
    f32x16 o[2];
#pragma unroll
    for (int i = 0; i < 16; ++i) { o[0][i] = 0.f; o[1][i] = 0.f; }
    const int kb_lo = (t0 / 32 - 4) > 0 ? (t0 / 32 - 4) : 0, kb_hi = (t0 / 32 + 4) < (T / 32 - 1) ? (t0 / 32 + 4) : (T / 32 - 1);
    for (int kb = kb_lo; kb <= kb_hi; ++kb) {
        const int kbl = 32 * kb - 256 * jb + 128;
        bf16x8 kf[4]; load_kfrag_lds(kf, kt, kbl + q, hi);
        f32x16 s;
#pragma unroll
        for (int i = 0; i < 16; ++i) s[i] = 0.f;
#pragma unroll
        for (int ks = 0; ks < 4; ++ks) s = MFMA32(kf[ks], qf[ks], s);
        const float base = (float)(t - 32 * kb - 4 * hi);
#pragma unroll
        for (int i = 0; i < 16; ++i) { const float d = base - (float)((i & 3) + 8 * (i >> 2)); s[i] = fmaf(s[i], CSC, -slope2 * fabsf(d)); }
        if (kb == t0 / 32 - 4 || kb == t0 / 32 + 4) {
#pragma unroll
            for (int i = 0; i < 16; ++i) { const float d = base - (float)((i & 3) + 8 * (i >> 2)); if (fabsf(d) > 128.0f) s[i] = -INFINITY; }
        }
        attn_step(s, m, l, o, vt, VSb, kbl, lane);
    }
    store_o(o, l, O + (size_t)(seqbase + t) * 1024 + hq * 64, hi);
}
__device__ __forceinline__ void mem_chunk(const LAS unsigned char* vt, int VSb, const LAS unsigned char* kt, const bf16x8 (&qf)[4], bf16* obase, int row0, int lane) {
    const int q = lane & 31, hi = lane >> 5;
    float m = -1e30f, l = 0.f;
    f32x16 o[2];
#pragma unroll
    for (int i = 0; i < 16; ++i) { o[0][i] = 0.f; o[1][i] = 0.f; }
    for (int kb = 0; kb < 8; ++kb) {
        bf16x8 kf[4]; load_kfrag_lds(kf, kt, 32 * kb + q, hi);
        f32x16 s;
#pragma unroll
        for (int i = 0; i < 16; ++i) s[i] = 0.f;
#pragma unroll
        for (int ks = 0; ks < 4; ++ks) s = MFMA32(kf[ks], qf[ks], s);
#pragma unroll
        for (int i = 0; i < 16; ++i) s[i] = s[i] * CSC;
        attn_step(s, m, l, o, vt, VSb, 32 * kb, lane);
    }
    store_o(o, l, obase + (size_t)(row0 + q) * 1024, hi);
}
__device__ __forceinline__ void na_chunk(const LAS unsigned char* vt, int VSb, const LAS float* rpbL, const bf16* kptr  , bf16* optr  ,
                                         const bf16x8 (&qf)[4], bf16x8 (&kf)[4], bf16x8 (&kf1)[4], int row_q, int c, int col0, int r0q, int kr_lo, int kr_hi, int klo, int lane) {
    const int hi = lane >> 5;
    int c0 = c - 8; c0 = c0 < 0 ? 0 : c0; c0 = c0 > 48 ? 48 : c0;
    float m = -1e30f, l = 0.f;
    f32x16 o[2];
#pragma unroll
    for (int i = 0; i < 16; ++i) { o[0][i] = 0.f; o[1][i] = 0.f; }
    int dcc[16];
#pragma unroll
    for (int ii = 0; ii < 16; ++ii) { const int kc = col0 + crow(ii, hi); dcc[ii] = ((unsigned)(kc - c0) < 16u) ? (kc - c + 15) : 31; }
    bf16x8 kn[4];
    for (int kr = kr_lo; kr <= kr_hi; ++kr) {
        if (kr + 2 <= kr_hi) load_frag4(kn, kptr + (size_t)(kr + 2 - kr_lo) * 64 * 2560);
        f32x16 s;
#pragma unroll
        for (int ii = 0; ii < 16; ++ii) s[ii] = 0.f;
#pragma unroll
        for (int ks = 0; ks < 4; ++ks) s = MFMA32(kf[ks], qf[ks], s);
        const int br = ((unsigned)(kr - r0q) < 8u) ? (kr - row_q + 7) : 15;
        const LAS float* brow = rpbL + br * 32;
#pragma unroll
        for (int ii = 0; ii < 16; ++ii) s[ii] = fmaf(s[ii], CSC, brow[dcc[ii]]);
        attn_step(s, m, l, o, vt, VSb, (kr - klo) * 64 + col0, lane);
#pragma unroll
        for (int ks = 0; ks < 4; ++ks) { kf[ks] = kf1[ks]; kf1[ks] = kn[ks]; }
    }
    store_o(o, l, optr, hi);
}

#define LDS_BARRIER() do { asm volatile("s_waitcnt lgkmcnt(0)" ::: "memory"); __builtin_amdgcn_s_barrier(); asm volatile("" ::: "memory"); } while (0)
constexpr int MEM_KT_OFF = 34816;
__device__ __forceinline__ void mem_units(LAS unsigned char* lds, const bf16* proj, int qpitch, int qcol, const bf16* mkv, int layer, bf16* O, int wave, int lane, int vcu) {
    const int N = NTILE * 4, G = gridDim.x;
    VRegs<2> VR; KRegs<4> KR; bf16x8 qn[4];
    const int ql = (lane & 31), qh = 8 * (lane >> 5);
    if (vcu < N) { const int hm = vcu / NTILE, pm = vcu - hm * NTILE; int seq, jb, T, seqbase; tile_seq(pm, seq, jb, T, seqbase);
        vt_load<2>(VR, mkv + layer * 512 + 256 + hm * 64, 1024, seq * 256, 0, 256); kt_load<4>(KR, mkv + layer * 512 + hm * 64, 1024, seq * 256, 0, 256);
        load_frag4(qn, proj + qcol + hm * 64 + (size_t)(pm * 256 + 32 * wave + ql) * qpitch + qh); }
    for (int u = vcu; u < N; u += G) {
        const int hm = u / NTILE, pm = u - hm * NTILE; int seq, jb, T, seqbase; tile_seq(pm, seq, jb, T, seqbase);
        bf16x8 qf[4];
#pragma unroll
        for (int ks = 0; ks < 4; ++ks) qf[ks] = qn[ks];
        LDS_BARRIER();
        vt_store<2>(VR, lds, 260, 0, 256); kt_store<4>(KR, lds + MEM_KT_OFF, 0, 256);
        LDS_BARRIER();
        const int un = u + G;
        if (un < N) { const int hm2 = un / NTILE, pm2 = un - hm2 * NTILE; int seq2, jb2, T2, sb2; tile_seq(pm2, seq2, jb2, T2, sb2);
            vt_load<2>(VR, mkv + layer * 512 + 256 + hm2 * 64, 1024, seq2 * 256, 0, 256); kt_load<4>(KR, mkv + layer * 512 + hm2 * 64, 1024, seq2 * 256, 0, 256);
            load_frag4(qn, proj + qcol + hm2 * 64 + (size_t)(pm2 * 256 + 32 * wave + ql) * qpitch + qh); }
        mem_chunk(lds, 260 * 2, lds + MEM_KT_OFF, qf, O + 768 + hm * 64, pm * 256 + 32 * wave, lane);
    }
}

#define LOAD_ARGS() \
    const CAS Args* ap_ = (const CAS Args*)__builtin_amdgcn_kernarg_segment_ptr(); asm volatile("" : "+s"(ap_)); \
    unsigned char* ws = ap_->ws; float* out = ap_->out; (void)out; \
    bf16* WinA = (bf16*)(ws + WS_WINA); bf16* WinB = (bf16*)(ws + WS_WINB); bf16* Wmkv = (bf16*)(ws + WS_WMKV); bf16* Wo = (bf16*)(ws + WS_WO); bf16* Wgu = (bf16*)(ws + WS_WGU); bf16* Wd = (bf16*)(ws + WS_WD); \
    float* SS = (float*)(ws + WS_SS); float* SSM = (float*)(ws + WS_SSM); bf16* MB = (bf16*)(ws + WS_MB); bf16* MKV = (bf16*)(ws + WS_MKV); float* SB = (float*)(ws + WS_SB); \
    bf16* XB = (bf16*)(ws + WS_XB); bf16* PROJ = (bf16*)(ws + WS_PROJ); bf16* OB = (bf16*)(ws + WS_O); bf16* ACT = (bf16*)(ws + WS_ACT); \
    (void)WinA; (void)WinB; (void)Wmkv; (void)Wo; (void)Wgu; (void)Wd; (void)SS; (void)SSM; (void)MB; (void)MKV; (void)SB; (void)XB; (void)PROJ; (void)OB; (void)ACT;
#define ARG(k) (ap_->in[k])
template <int layer>
__device__ __forceinline__ void layer_phases(LAS unsigned char* lds, LAS float* ldsx, const int lo, const int hi_ph, const int G, const int bx) {
    int tid = threadIdx.x; asm volatile("" : "+v"(tid));
    const int lane = tid & 63, wave = __builtin_amdgcn_readfirstlane(tid >> 6);
#define IN(k) (lo <= (k) && (k) < hi_ph)
#define SEAM(k) do { if (IN(k) && IN((k) + 1)) { if ((k) == 0) cg::this_grid().sync(); else { const CAS Args* apb_ = (const CAS Args*)__builtin_amdgcn_kernarg_segment_ptr(); asm volatile("" : "+s"(apb_)); xcd_barrier((unsigned*)(apb_->ws + WS_CTL), (volatile LAS unsigned*)(lds + MISC_OFF)); } } } while (0)
        const int pb = 1 + 6 * layer;
        const int NP = layer == 0 ? 1536 : 2560;
        if (IN(pb)) {
            LOAD_ARGS();
            for (int rep = 0; rep < NREP(1); ++rep)
            { pg8::Gemm g{XB, layer == 0 ? WinA : WinB, MTOK, NP, D, 0}; pg8::StaticOrder S; S.init(MTOK, NP, G, bx);
              pg8::EpiScaleBf16 E{PROJ, NP, SS};
              pg8::gemm_phase<pg8::EpiScaleBf16, pg8::StaticOrder>(lds, g, S, E); }
            { pg8::Gemm g{MB, Wmkv + (size_t)layer * 512 * 1024, MMEM, 512, D, 0}; pg8::StaticOrder S; S.init(MMEM, 512, G, (bx + G / 2) % G);
              pg8::EpiScaleBf16 E{MKV + layer * 512, 1024, SSM};
              pg8::gemm_phase<pg8::EpiScaleBf16, pg8::StaticOrder>(lds, g, S, E); }
        }
        SEAM(pb);
        if (IN(pb + 1)) {
            LOAD_ARGS();
            const float* sink_a = ARG(7); const float* rpb_b = ARG(9);
            const int vcu = (G % 8 == 0) ? (bx % 8) * (G / 8) + bx / 8 : bx;
            if (layer == 0) {
                {
                    const int N = NTILE * 4;
                    VRegs<4> VR; KRegs<8> KR; bf16x8 qn[4]; LAS unsigned char* ktw = lds + 69632;
                    if (vcu < N) { const int g = vcu / NTILE, pm = vcu - g * NTILE; int seq, jb, T, seqbase; tile_seq(pm, seq, jb, T, seqbase);
                        const int kl_lo = (jb == 0) ? 128 : 0; int kl_hi = T - 256 * jb + 128; kl_hi = kl_hi > 512 ? 512 : kl_hi;
                        vt_load<4>(VR, PROJ + 1024 + g * 64, 1536, seqbase + 256 * jb - 128, kl_lo, kl_hi); kt_load<8>(KR, PROJ + 768 + g * 64, 1536, seqbase + 256 * jb - 128, kl_lo, kl_hi);
                        { const int c0_ = 3 * wave, r0_ = c0_ >> 3, qc0_ = c0_ & 7; load_frag4(qn, PROJ + (size_t)(seqbase + 256 * jb + 32 * qc0_ + (lane & 31)) * 1536 + (3 * g + r0_) * 64 + 8 * (lane >> 5)); } }
                    for (int u = vcu; u < N; u += G) {
                        const int g = u / NTILE, pm = u - g * NTILE; int seq, jb, T, seqbase; tile_seq(pm, seq, jb, T, seqbase);
                        const int kl_lo = (jb == 0) ? 128 : 0; int kl_hi = T - 256 * jb + 128; kl_hi = kl_hi > 512 ? 512 : kl_hi;
                        LDS_BARRIER();
                        vt_store<4>(VR, lds, 516, kl_lo, kl_hi); kt_store<8>(KR, ktw, kl_lo, kl_hi);
                        LDS_BARRIER();
                        const int un = u + G;
                        if (un < N) { const int g2 = un / NTILE, pm2 = un - g2 * NTILE; int seq2, jb2, T2, sb2; tile_seq(pm2, seq2, jb2, T2, sb2);
                            const int kl_lo2 = (jb2 == 0) ? 128 : 0; int kl_hi2 = T2 - 256 * jb2 + 128; kl_hi2 = kl_hi2 > 512 ? 512 : kl_hi2;
                            vt_load<4>(VR, PROJ + 1024 + g2 * 64, 1536, sb2 + 256 * jb2 - 128, kl_lo2, kl_hi2); kt_load<8>(KR, PROJ + 768 + g2 * 64, 1536, sb2 + 256 * jb2 - 128, kl_lo2, kl_hi2); }
#pragma unroll 1
                        for (int i = 0; i < 3; ++i) { const int cidx = 3 * wave + i, r = cidx >> 3, qc = cidx & 7;
                            bf16x8 qf[4];
#pragma unroll
                            for (int ks = 0; ks < 4; ++ks) qf[ks] = qn[ks];
                            {
                                int u2 = u, i2 = i + 1; if (i2 == 3) { i2 = 0; u2 = u + G; }
                                if (u2 < N) { const int g2 = u2 / NTILE, pm2 = u2 - g2 * NTILE; int seq2, jb2, T2, sb2; tile_seq(pm2, seq2, jb2, T2, sb2);
                                    const int c2 = 3 * wave + i2, r2 = c2 >> 3, qc2 = c2 & 7;
                                    load_frag4(qn, PROJ + (size_t)(sb2 + 256 * jb2 + 32 * qc2 + (lane & 31)) * 1536 + (3 * g2 + r2) * 64 + 8 * (lane >> 5)); }
                            }
                            window_chunk(lds, 516 * 2, ktw, qf, OB, seqbase, T, jb, g, r, qc, sink_a[3 * g + r], lane); }
                    }
                }
                mem_units(lds, PROJ, 1536, 1280, MKV, 0, OB, wave, lane, vcu);
            } else {
                LAS float* rpbL = (LAS float*)(lds + 98304);
                {
                    const int N = NTILE * 12;
                    VRegs<6> VR; float rpbv = 0.f; bf16x8 qn[4], kn0[4];
#define NA_QK(uu_) { NA_DESC(uu_, hq_, jbq_, sbq_, rowsq_, kloq_, khiq_); (void)kloq_; (void)khiq_; const int rpq_ = wave >> 2, aq_ = wave & 3, qq_ = lane & 31, hiq_ = lane >> 5; \
                        const int rAq_ = 4 * jbq_ + 2 * rpq_, rowq_ = rAq_ + (qq_ >> 4), cq_ = 16 * aq_ + (qq_ & 15); int col0q_ = 16 * aq_ - 8; col0q_ = col0q_ < 0 ? 0 : col0q_; col0q_ = col0q_ > 32 ? 32 : col0q_; \
                        int krq_ = rAq_ - 4; krq_ = krq_ < 0 ? 0 : krq_; krq_ = krq_ > rowsq_ - 8 ? rowsq_ - 8 : krq_; \
                        const bf16* kpq_ = PROJ + 768 + hq_ * 64 + 8 * hiq_ + (size_t)(sbq_ + krq_ * 64 + col0q_ + qq_) * 2560; \
                        load_frag4(qn, PROJ + (size_t)(sbq_ + rowq_ * 64 + cq_) * 2560 + hq_ * 64 + 8 * hiq_); load_frag4(kn0, kpq_); }
#define NA_DESC(uu_, h_, jb_, sb_, rows_, klo_, khi_) const int h_ = (uu_) / NTILE; int jb_, sb_, rows_, klo_, khi_; { const int pm_ = (uu_) - h_ * NTILE; int seq_, T_; tile_seq(pm_, seq_, jb_, T_, sb_); rows_ = T_ / 64; \
                        klo_ = 4 * jb_ - 4; klo_ = klo_ < 0 ? 0 : klo_; klo_ = klo_ > rows_ - 8 ? rows_ - 8 : klo_; khi_ = 4 * jb_ + 3 - 4; khi_ = khi_ < 0 ? 0 : khi_; khi_ = khi_ > rows_ - 8 ? rows_ - 8 : khi_; khi_ += 8; }
                    if (vcu < N) { NA_DESC(vcu, h0, jb0, sb0, rows0, klo0, khi0);
                        vt_load<6>(VR, PROJ + 1536 + h0 * 64, 2560, sb0 + klo0 * 64, 0, (khi0 - klo0) * 64); { const int tr = tid >> 5, tc = tid & 31; rpbv = (tr < 15 && tc < 31) ? rpb_b[h0 * 465 + tr * 31 + tc] * LOG2E : -INFINITY; } NA_QK(vcu); }
                    for (int u = vcu; u < N; u += G) {
                        NA_DESC(u, h, jb, seqbase, rows, klo, khi);
                        const int rp = wave >> 2, a = wave & 3, q = lane & 31, hi = lane >> 5;
                        const int rA = 4 * jb + 2 * rp, row_q = rA + (q >> 4), c = 16 * a + (q & 15);
                        int col0 = 16 * a - 8; col0 = col0 < 0 ? 0 : col0; col0 = col0 > 32 ? 32 : col0;
                        int r0q = row_q - 4; r0q = r0q < 0 ? 0 : r0q; r0q = r0q > rows - 8 ? rows - 8 : r0q;
                        int kr_lo = rA - 4; kr_lo = kr_lo < 0 ? 0 : kr_lo; kr_lo = kr_lo > rows - 8 ? rows - 8 : kr_lo;
                        int kr_hi = rA + 1 - 4; kr_hi = kr_hi < 0 ? 0 : kr_hi; kr_hi = kr_hi > rows - 8 ? rows - 8 : kr_hi; kr_hi += 7;
                        const bf16* kptr = PROJ + 768 + h * 64 + 8 * hi + (size_t)(seqbase + kr_lo * 64 + col0 + q) * 2560;
                        bf16x8 qf[4], kf[4], kf1[4];
#pragma unroll
                        for (int ks = 0; ks < 4; ++ks) { qf[ks] = qn[ks]; kf[ks] = kn0[ks]; }
                        load_frag4(kf1, kptr + (size_t)64 * 2560);
                        LDS_BARRIER();
                        vt_store<6>(VR, lds, 708, 0, (khi - klo) * 64);
                        rpbL[tid] = rpbv;
                        LDS_BARRIER();
                        const int un = u + G;
                        if (un < N) { NA_DESC(un, h2, jb2, sb2, rows2, klo2, khi2);
                            vt_load<6>(VR, PROJ + 1536 + h2 * 64, 2560, sb2 + klo2 * 64, 0, (khi2 - klo2) * 64); { const int tr = tid >> 5, tc = tid & 31; rpbv = (tr < 15 && tc < 31) ? rpb_b[h2 * 465 + tr * 31 + tc] * LOG2E : -INFINITY; } NA_QK(un); }
                        na_chunk(lds, 708 * 2, rpbL, kptr, OB + (size_t)(seqbase + row_q * 64 + c) * 1024 + h * 64, qf, kf, kf1, row_q, c, col0, r0q, kr_lo, kr_hi, klo, lane);
                    }
#undef NA_QK
#undef NA_DESC
                }
                mem_units(lds, PROJ, 2560, 2304, MKV, 1, OB, wave, lane, vcu);
            }
        }
        SEAM(pb + 1);
        if (IN(pb + 2)) {
            LOAD_ARGS();
            pg8::Gemm g{OB, Wo + (size_t)layer * 1024 * 1024, MTOK, D, D, 0}; pg8::StaticOrder S; S.init(MTOK, D, G, bx);
            pg8::EpiResid E{XB, SS, ldsx};
            pg8::gemm_phase<pg8::EpiResid, pg8::StaticOrder>(lds, g, S, E);
        }
        SEAM(pb + 2);
        if (IN(pb + 3)) {
            LOAD_ARGS();
            const float* conv_w = ARG(15); const float* conv_b = ARG(16);
            pg8::Gemm g{XB, Wgu + (size_t)layer * 5632 * 1024, MTOK, 5632, D, 0}; pg8::StaticOrder S; S.init(MTOK, 5632, G, bx);
            pg8::EpiGateUp E{ACT, SS, conv_w + (size_t)layer * 3 * FF, conv_b + (size_t)layer * FF, SB, ldsx};
            if (tid < 128) { ldsx[tid] = 0.f; ldsx[(17 + 16) * 128 + tid] = 0.f; }
            __syncthreads();
            for (int rep = 0; rep < NREP(6); ++rep) pg8::gemm_phase<pg8::EpiGateUp, pg8::StaticOrder>(lds, g, S, E);
        }
        SEAM(pb + 3);
        if (IN(pb + 4)) {
            LOAD_ARGS();
            const float* conv_w = ARG(15);
            const float* cw = conv_w + (size_t)layer * 3 * FF;
            for (int idx = bx * (NWAVES * 64) + tid; idx < NTILE * 2 * FF; idx += G * NWAVES * 64) {
                const int col = idx % FF, pw = idx / FF, pm = pw >> 1, which = pw & 1;
                const float part = SB[(size_t)(pw * 3 + 1) * FF + col], uu = SB[(size_t)(pw * 3 + 2) * FF + col];
                const bool seq_start = (pm < 256) ? ((pm & 7) == 0) : (pm == 256);
                const bool seq_end = (pm < 256) ? ((pm & 7) == 7) : (pm == NTILE - 1);
                float c = part;
                if (which == 0) { if (!seq_start) c += cw[col] * SB[(size_t)(((pm - 1) * 2 + 1) * 3) * FF + col]; }
                else { if (!seq_end) c += cw[2 * FF + col] * SB[(size_t)(((pm + 1) * 2) * 3) * FF + col]; }
                const float sg = 1.0f / (1.0f + __builtin_amdgcn_exp2f(-LOG2E * c));
                ACT[pg8::ilv_off(pm * 256 + (which ? 255 : 0), col, FF)] = (bf16)f2bf(c * sg * uu);
            }
        }
        SEAM(pb + 4);
        if (IN(pb + 5)) {
            LOAD_ARGS();
            pg8::Gemm g{ACT, Wd + (size_t)layer * 1024 * FF, MTOK, D, FF, 1}; pg8::StaticOrder S; S.init(MTOK, D, G, bx);
            if constexpr (layer == 0) {
                pg8::EpiResid E{XB, SS, ldsx};
                pg8::gemm_phase<pg8::EpiResid, pg8::StaticOrder>(lds, g, S, E);
            } else {
                pg8::EpiFinal E{XB, out, ARG(18), (float*)(ws + WS_XS), (unsigned*)(ws + WS_CTL) + CW_PANEL, ldsx};
                pg8::gemm_phase<pg8::EpiFinal, pg8::StaticOrder>(lds, g, S, E);
            }
        }
        if constexpr (layer == 0) { SEAM(pb + 5); }
#undef IN
#undef SEAM
}

__global__ void __launch_bounds__(NWAVES * 64, 2) mega_fwd(Args args) {
    extern __shared__ __attribute__((aligned(16))) unsigned char lds_raw[];
    LAS unsigned char* lds = (LAS unsigned char*)lds_raw;
    const int G = gridDim.x, bx = blockIdx.x;
    if (threadIdx.x < 16) ((volatile LAS unsigned*)(lds + MISC_OFF))[threadIdx.x] = 0u;
    __syncthreads();
    { const CAS Args* apc_ = (const CAS Args*)__builtin_amdgcn_kernarg_segment_ptr(); if (apc_->ph_hi - apc_->ph_lo > 1 && threadIdx.x == 0) (void)xb_add((unsigned*)(apc_->ws + WS_CTL) + XB_XCNT(xb_xcc_id()), 1u); }
#define PHASE_TID() int tid = threadIdx.x; asm volatile("" : "+v"(tid)); const int lane = tid & 63, wave = __builtin_amdgcn_readfirstlane(tid >> 6); (void)lane; (void)wave;
    LAS float* ldsx = (LAS float*)(lds + LDS_X_OFF);

    int lo, hi_ph; { const CAS Args* ap0 = (const CAS Args*)__builtin_amdgcn_kernarg_segment_ptr(); lo = ap0->ph_lo; hi_ph = ap0->ph_hi; }
#define IN(k) (lo <= (k) && (k) < hi_ph)
#define SEAM(k) do { if (IN(k) && IN((k) + 1)) { if ((k) == 0) cg::this_grid().sync(); else { const CAS Args* apb_ = (const CAS Args*)__builtin_amdgcn_kernarg_segment_ptr(); asm volatile("" : "+s"(apb_)); xcd_barrier((unsigned*)(apb_->ws + WS_CTL), (volatile LAS unsigned*)(lds + MISC_OFF)); } } } while (0)

    if (IN(0)) {
        LOAD_ARGS(); PHASE_TID();
        const float* x_prompt = ARG(0); const float* x_sample = ARG(1); const float* mem_prompt = ARG(2); const float* mem_sample = ARG(3); const float* g_mix = ARG(4); const float* g_mem = ARG(5);
        const float* w_in_a = ARG(6); const float* w_in_b = ARG(8); const float* w_mem_kv = ARG(10); const float* w_o = ARG(11); const float* g_ffn = ARG(12); const float* w_gate = ARG(13); const float* w_up = ARG(14); const float* w_down = ARG(17);
        LAS float* scr = (LAS float*)(lds + wave * 16384);
        const int gw = bx * NWAVES + wave, NGW = G * NWAVES;
        constexpr int I_INA = 16 * 48, I_INB = 16 * 80, I_MKV = 16 * 16, I_O = 16 * 32, I_G = 16 * 88, I_D = 44 * 32;
        constexpr int NITEMS = I_INA + I_INB + 2 * I_MKV + 2 * I_O + 4 * I_G + 2 * I_D;
        for (int rep = 0; rep < NREP(0); ++rep) {
        for (int it = gw; it < NITEMS; it += NGW) {
            int r = it;
            if (r < I_INA) { p0_transpose_item(w_in_a, 1024, 1536, WinA, 0, 0, g_mix, scr, r, lane); continue; } r -= I_INA;
            if (r < I_INB) { p0_transpose_item(w_in_b, 1024, 2560, WinB, 0, 0, g_mix + 1024, scr, r, lane); continue; } r -= I_INB;
            if (r < 2 * I_MKV) { const int li = r / I_MKV; p0_transpose_item(w_mem_kv + (size_t)li * 1024 * 512, 1024, 512, Wmkv, li * 512, 0, g_mem + li * 1024, scr, r % I_MKV, lane); continue; } r -= 2 * I_MKV;
            if (r < 2 * I_O) { const int li = r / I_O; p0_transpose_item(w_o + (size_t)li * 1024 * 1024, 1024, 1024, Wo + (size_t)li * 1024 * 1024, 0, 0, nullptr, scr, r % I_O, lane); continue; } r -= 2 * I_O;
            if (r < 4 * I_G) { const int li = r / (2 * I_G), rr = r % (2 * I_G), isup = rr / I_G;
                p0_transpose_item((isup ? w_up : w_gate) + (size_t)li * 1024 * FF, 1024, FF, Wgu + (size_t)li * 5632 * 1024, 0, 1 + isup, g_ffn + li * 1024, scr, rr % I_G, lane); continue; } r -= 4 * I_G;
            { const int li = r / I_D; p0_transpose_item(w_down + (size_t)li * FF * 1024, FF, 1024, Wd + (size_t)li * 1024 * FF, 0, 0, nullptr, scr, r % I_D, lane); }
        }
        constexpr int RU = 4;
        for (int m0 = gw; m0 < MTOK + MMEM; m0 += RU * NGW) {
            f32x4 v[RU][4];
#pragma unroll
            for (int r = 0; r < RU; ++r) {
                const int m = m0 + r * NGW;
                if (m < MTOK + MMEM) {
                    const float* xr = m < MPROMPT ? x_prompt + (size_t)m * D : m < MTOK ? x_sample + (size_t)(m - MPROMPT) * D : (m - MTOK) < 8192 ? mem_prompt + (size_t)(m - MTOK) * D : mem_sample + (size_t)(m - MTOK - 8192) * D;
                    const f32x4* xp = (const f32x4*)xr + lane;
#pragma unroll
                    for (int j = 0; j < 4; ++j) v[r][j] = xp[64 * j];
                }
            }
#pragma unroll
            for (int r = 0; r < RU; ++r) {
                const int m = m0 + r * NGW;
                if (m < MTOK + MMEM) {
                    float sq = 0.f;
#pragma unroll
                    for (int j = 0; j < 4; ++j) sq += (v[r][j].x * v[r][j].x + v[r][j].y * v[r][j].y) + (v[r][j].z * v[r][j].z + v[r][j].w * v[r][j].w);
                    sq = wave_sum(sq);
                    bf16* orow = m < MTOK ? XB + (size_t)m * D : MB + (size_t)(m - MTOK) * D;
                    float* ssrow = m < MTOK ? SS + (size_t)m * 4 : SSM + (size_t)(m - MTOK) * 4;
                    u32x2* o8 = (u32x2*)orow + lane;
#pragma unroll
                    for (int j = 0; j < 4; ++j) { u32x2 w; w.x = pk2(v[r][j].x, v[r][j].y); w.y = pk2(v[r][j].z, v[r][j].w); o8[64 * j] = w; }
                    if (lane == 0) *(f32x4*)ssrow = (f32x4){sq, 0.f, 0.f, 0.f};
                }
            }
        }
        }
    }
    SEAM(0);

    layer_phases<0>(lds, ldsx, lo, hi_ph, G, bx);
    layer_phases<1>(lds, ldsx, lo, hi_ph, G, bx);
#undef IN
#undef SEAM
}

constexpr int N_PHASES = 13;
extern "C" void kernel_launch(void* const* d_in, const int* in_sizes, int n_in, void* d_out, int out_size, void* d_ws, size_t ws_size, hipStream_t stream) {
    static int grid = 0;
    if (grid == 0) {
        if (n_in != 19 || out_size != MTOK * D || ws_size < WS_END) { fprintf(stderr, "kernel_launch: unexpected shapes n_in %d out %d ws %zu\n", n_in, out_size, ws_size); grid = -1; return; }
        int dev = 0, cus = 0, per_cu = 0;
        if (hipGetDevice(&dev) != hipSuccess || hipDeviceGetAttribute(&cus, hipDeviceAttributeMultiprocessorCount, dev) != hipSuccess) { grid = -1; return; }
        if (hipFuncSetAttribute((const void*)mega_fwd, hipFuncAttributeMaxDynamicSharedMemorySize, LDS_BYTES) != hipSuccess) { fprintf(stderr, "kernel_launch: hipFuncSetAttribute failed\n"); grid = -1; return; }
        if (hipOccupancyMaxActiveBlocksPerMultiprocessor(&per_cu, (const void*)mega_fwd, NWAVES * 64, LDS_BYTES) != hipSuccess || per_cu < 1) { fprintf(stderr, "kernel_launch: occupancy query says %d\n", per_cu); per_cu = 1; }
        (void)hipGetLastError();
        grid = cus * 1;
    }
    if (grid < 0) return;
    if (hipMemsetAsync((char*)d_ws + WS_CTL, 0, CTL_ZERO_BYTES, stream) != hipSuccess) { fprintf(stderr, "kernel_launch: memset failed\n"); return; }
    Args a{};
    for (int i = 0; i < 19; ++i) a.in[i] = (const float*)d_in[i];
    a.out = (float*)d_out; a.ws = (unsigned char*)d_ws;
#if MK_ONE_LAUNCH
    a.ph_lo = 0; a.ph_hi = N_PHASES;
    void* kargs[] = {&a};
    hipError_t e = hipLaunchCooperativeKernel((const void*)mega_fwd, dim3(grid), dim3(NWAVES * 64), kargs, LDS_BYTES, stream);
    if (e != hipSuccess) fprintf(stderr, "cooperative launch failed: %s (grid %d)\n", hipGetErrorString(e), grid);
#else
    for (int p = 0; p < N_PHASES; ++p) { a.ph_lo = p; a.ph_hi = p + 1; hipLaunchKernelGGL(mega_fwd, dim3(grid), dim3(NWAVES * 64), LDS_BYTES, stream, a); }
#endif
}
```

```cpp
#include <hip/hip_runtime.h>
#include <hip/hip_cooperative_groups.h>
#include <cstdio>
#include <cstdint>
namespace cg = cooperative_groups;

#ifndef PROBE_REP
#define PROBE_REP 0
#endif
#define NREP(k) (((PROBE_REP >> (k)) & 1) ? 2 : 1)
#ifndef MK_ONE_LAUNCH
#define MK_ONE_LAUNCH 1
#endif

namespace pg8 {
#define PG8_LAS __attribute__((address_space(3)))
typedef unsigned short bf16_t;
typedef short bf16x8 __attribute__((ext_vector_type(8)));
typedef float f32x4 __attribute__((ext_vector_type(4)));
typedef unsigned u32x4 __attribute__((ext_vector_type(4)));
typedef unsigned u32x2 __attribute__((ext_vector_type(2)));
constexpr int BM = 256, BK = 64, HALF = 128, HTB = HALF * BK * 2, STAGE_BYTES = 8 * HTB, NXCD = 8, WGM = 8;

__host__ __device__ __forceinline__ int lds_byte(int r, int c) { const int st = (r >> 4) * 2 + (c >> 5), rr = r & 15, cc = c & 31, ob = rr * 64 + cc * 2; return st * 1024 + (ob ^ (((ob >> 9) & 1) << 5)); }
__host__ __device__ __forceinline__ void stage_rc(int b, int& R, int& C) { const int st = b / 1024, sb = b % 1024, swz = sb ^ (((sb >> 9) & 1) << 5); R = (st >> 1) * 16 + swz / 64; C = (st & 1) * 32 + (swz % 64) / 2; }
__host__ __device__ __forceinline__ int perm32(int rho) { const int n = rho >> 4, i = rho & 15; return 8 * (i >> 2) + 4 * n + (i & 3); }

__host__ __device__ __forceinline__ size_t ilv_off(int r, int k, int K) { return (size_t)(r >> 4) * (16 * (size_t)K) + (size_t)(r & 7) * (2 * (size_t)K) + (size_t)(k >> 5) * 64 + (size_t)((r >> 3) & 1) * 32 + (k & 31); }
struct Unit { int pm, pn; };
struct Gemm { const bf16_t* A; const bf16_t* Bt; int M, N, K, ailv; };

struct StaticOrder {
    int nM, nN, nwg, G, c;
    __host__ __device__ void init(int M, int N, int G_, int c_) { nM = M / BM; nN = N / BM; nwg = nM * nN; G = G_; c = c_; }
    __host__ __device__ bool next(int i, Unit& u) const {
        const long L = (long)i * G + c; if (L >= nwg) return false;
        int wgid = (int)L; { const int q = nwg / NXCD, r = nwg % NXCD, xcd = wgid % NXCD, off = wgid / NXCD; wgid = (xcd < r ? xcd * (q + 1) : r * (q + 1) + (xcd - r) * q) + off; }
        const int nig = WGM * nN, gid = wgid / nig, fm = gid * WGM, gsz = (nM - fm) < WGM ? (nM - fm) : WGM;
        u.pm = fm + ((wgid % nig) % gsz); u.pn = (wgid % nig) / gsz; return true;
    }
};

__device__ __forceinline__ unsigned cvt_pk_bf16(float lo, float hi) { unsigned r; asm volatile("v_cvt_pk_bf16_f32 %0, %1, %2" : "=v"(r) : "v"(lo), "v"(hi)); return r; }
__device__ __forceinline__ float rstd_of(const float* ss, int row) { const f32x4 p = *(const f32x4*)(ss + (size_t)row * 4); return __builtin_amdgcn_rsqf(((p[0] + p[1]) + (p[2] + p[3])) * (1.0f / 1024.0f) + 1e-6f); }


__device__ __forceinline__ u32x4 xchg8(const u32x4 v) {
    u32x4 r;
#pragma unroll
    for (int i = 0; i < 4; ++i) r[i] = (unsigned)__builtin_amdgcn_update_dpp(0, (int)v[i], 0x128, 0xf, 0xf, true);
    return r;
}
__device__ __forceinline__ u32x4 sel4(bool c, const u32x4 a, const u32x4 b) { u32x4 r; r.x = c ? a.x : b.x; r.y = c ? a.y : b.y; r.z = c ? a.z : b.z; r.w = c ? a.w : b.w; return r; }

struct EpiScaleBf16 {
    static constexpr bool PERM = true;
    bf16_t* O; int ldc; const float* ss;
    __device__ __forceinline__ void operator()(f32x4 (&acc)[2][2][4][2], const Unit& u, int wr, int wc, int fr, int fq) const {
        asm volatile("" : "+v"(fr), "+v"(fq)); asm volatile("" : "+s"(wr), "+s"(wc));
        const bool lo = fr < 8;
        const int row0 = u.pm * BM + wr * 64 + fr, col0 = u.pn * BM + wc * 64 + 8 * fq;
        bf16_t* base = O + (size_t)(u.pm * BM + wr * 64 + (fr & 7)) * ldc + col0 + (lo ? 0 : 32);
#pragma unroll
        for (int ai = 0; ai < 2; ++ai)
#pragma unroll
            for (int m = 0; m < 4; ++m) {
                const float rs = rstd_of(ss, row0 + ai * HALF + m * 16);
                u32x4 w[2];
#pragma unroll
                for (int bj = 0; bj < 2; ++bj) { const f32x4 v0 = acc[ai][bj][m][0] * rs, v1 = acc[ai][bj][m][1] * rs;
                    w[bj].x = cvt_pk_bf16(v0[0], v0[1]); w[bj].y = cvt_pk_bf16(v0[2], v0[3]); w[bj].z = cvt_pk_bf16(v1[0], v1[1]); w[bj].w = cvt_pk_bf16(v1[2], v1[3]); }
                const u32x4 y = xchg8(sel4(lo, w[1], w[0]));
                bf16_t* rp = base + (size_t)(ai * HALF + m * 16) * ldc;
                *(u32x4*)rp = sel4(lo, w[0], y);
                *(u32x4*)(rp + (size_t)8 * ldc) = sel4(lo, y, w[1]);
            }
    }
};

__device__ __forceinline__ f32x4 bf_lo4(unsigned w0, unsigned w1) { return (f32x4){__builtin_bit_cast(float, w0 << 16), __builtin_bit_cast(float, w0 & 0xffff0000u), __builtin_bit_cast(float, w1 << 16), __builtin_bit_cast(float, w1 & 0xffff0000u)}; }
struct EpiResid {
    static constexpr bool PERM = true;
    bf16_t* xb; float* ss; PG8_LAS float* red;
    __device__ __forceinline__ void operator()(f32x4 (&acc)[2][2][4][2], const Unit& u, int wr, int wc, int fr, int fq) const {
        asm volatile("" : "+v"(fr), "+v"(fq)); asm volatile("" : "+s"(wr), "+s"(wc));
        const bool lo = fr < 8;
        const int col0 = u.pn * BM + wc * 64 + 8 * fq;
        bf16_t* base = xb + (size_t)(u.pm * BM + wr * 64 + (fr & 7)) * 1024 + col0 + (lo ? 0 : 32);
#pragma unroll
        for (int ai = 0; ai < 2; ++ai)
#pragma unroll
            for (int m = 0; m < 4; ++m) {
                const int rl = ai * HALF + wr * 64 + m * 16 + fr;
                bf16_t* rp = base + (size_t)(ai * HALF + m * 16) * 1024;
                const u32x4 la = *(const u32x4*)rp, lb = *(const u32x4*)(rp + (size_t)8 * 1024);
                const u32x4 yi = xchg8(sel4(lo, lb, la));
                u32x4 xo[2]; xo[0] = sel4(lo, la, yi); xo[1] = sel4(lo, yi, lb);
                float sq = 0.f; u32x4 w[2];
#pragma unroll
                for (int bj = 0; bj < 2; ++bj) {
                    const f32x4 v0 = acc[ai][bj][m][0] + bf_lo4(xo[bj].x, xo[bj].y), v1 = acc[ai][bj][m][1] + bf_lo4(xo[bj].z, xo[bj].w);
                    sq += (v0[0] * v0[0] + v0[1] * v0[1]) + (v0[2] * v0[2] + v0[3] * v0[3]) + (v1[0] * v1[0] + v1[1] * v1[1]) + (v1[2] * v1[2] + v1[3] * v1[3]);
                    w[bj].x = cvt_pk_bf16(v0[0], v0[1]); w[bj].y = cvt_pk_bf16(v0[2], v0[3]); w[bj].z = cvt_pk_bf16(v1[0], v1[1]); w[bj].w = cvt_pk_bf16(v1[2], v1[3]);
                }
                const u32x4 yo = xchg8(sel4(lo, w[1], w[0]));
                *(u32x4*)rp = sel4(lo, w[0], yo); *(u32x4*)(rp + (size_t)8 * 1024) = sel4(lo, yo, w[1]);
                sq += __shfl_xor(sq, 16); sq += __shfl_xor(sq, 32);
                if (fq == 0) red[rl * 4 + wc] = sq;
            }
        asm volatile("s_waitcnt lgkmcnt(0)" ::: "memory"); __builtin_amdgcn_s_barrier(); asm volatile("" ::: "memory");
        const int tid = threadIdx.x;
        if (tid < 256) { const f32x4 p = *(const PG8_LAS f32x4*)(red + tid * 4); ss[(size_t)(u.pm * BM + tid) * 4 + u.pn] = (p[0] + p[1]) + (p[2] + p[3]); }
    }
};

struct EpiFinal {
    static constexpr bool PERM = true;
    const bf16_t* xb; float* xout; const float* gfin; float* xs; unsigned* cnt; PG8_LAS float* red;
    __device__ __forceinline__ void operator()(f32x4 (&acc)[2][2][4][2], const Unit& u, int wr, int wc, int fr, int fq) const {
        asm volatile("" : "+v"(fr), "+v"(fq)); asm volatile("" : "+s"(wr), "+s"(wc));
        const int col0 = u.pn * BM + wc * 64 + 8 * fq;
#pragma unroll
        for (int ai = 0; ai < 2; ++ai)
#pragma unroll
            for (int m = 0; m < 4; ++m) {
                const int rl = ai * HALF + wr * 64 + m * 16 + fr, row = u.pm * BM + rl;
                const bf16_t* xi = xb + (size_t)row * 1024 + col0;
                float sq = 0.f;
#pragma unroll
                for (int bj = 0; bj < 2; ++bj) {
                    const u32x4 xo = *(const u32x4*)(xi + bj * 32);
                    const f32x4 v0 = acc[ai][bj][m][0] + bf_lo4(xo.x, xo.y), v1 = acc[ai][bj][m][1] + bf_lo4(xo.z, xo.w);
                    sq += (v0[0] * v0[0] + v0[1] * v0[1]) + (v0[2] * v0[2] + v0[3] * v0[3]) + (v1[0] * v1[0] + v1[1] * v1[1]) + (v1[2] * v1[2] + v1[3] * v1[3]);
                    acc[ai][bj][m][0] = v0; acc[ai][bj][m][1] = v1;
                }
                sq += __shfl_xor(sq, 16); sq += __shfl_xor(sq, 32);
                if (fq == 0) red[rl * 4 + wc] = sq;
            }
        asm volatile("s_waitcnt lgkmcnt(0)" ::: "memory"); __builtin_amdgcn_s_barrier(); asm volatile("" ::: "memory");
        const int tid = threadIdx.x;
        unsigned* cw_ = cnt + 64 * u.pm;
        if (tid < 256) {
            const f32x4 p = *(const PG8_LAS f32x4*)(red + tid * 4);
            __hip_atomic_store(xs + (size_t)(u.pm * 4 + u.pn) * 256 + tid, (p[0] + p[1]) + (p[2] + p[3]), __ATOMIC_RELAXED, __HIP_MEMORY_SCOPE_AGENT);
            asm volatile("s_waitcnt vmcnt(0)" ::: "memory");
            if ((tid & 63) == 0) __hip_atomic_fetch_add(cw_, 1u, __ATOMIC_RELAXED, __HIP_MEMORY_SCOPE_AGENT);
        }
        if (tid < 64) {
            unsigned sp = 0u;
            while ((unsigned)__builtin_amdgcn_readfirstlane(__hip_atomic_load(cw_, __ATOMIC_RELAXED, __HIP_MEMORY_SCOPE_AGENT)) < 16u) { __builtin_amdgcn_s_sleep(2); if (++sp > (1u << 24)) break; }
            __builtin_amdgcn_fence(__ATOMIC_ACQUIRE, "agent");
        }
        asm volatile("s_waitcnt vmcnt(0) lgkmcnt(0)" ::: "memory"); __builtin_amdgcn_s_barrier(); asm volatile("" ::: "memory");
        if (tid < 256) {
            const float* xp = xs + (size_t)(u.pm * 4) * 256 + tid;
            const float t0 = __hip_atomic_load(xp, __ATOMIC_RELAXED, __HIP_MEMORY_SCOPE_AGENT), t1 = __hip_atomic_load(xp + 256, __ATOMIC_RELAXED, __HIP_MEMORY_SCOPE_AGENT),
                        t2 = __hip_atomic_load(xp + 512, __ATOMIC_RELAXED, __HIP_MEMORY_SCOPE_AGENT), t3 = __hip_atomic_load(xp + 768, __ATOMIC_RELAXED, __HIP_MEMORY_SCOPE_AGENT);
            red[1024 + tid] = __builtin_amdgcn_rsqf(((t0 + t1) + (t2 + t3)) * (1.0f / 1024.0f) + 1e-6f);
        }
        asm volatile("s_waitcnt lgkmcnt(0)" ::: "memory"); __builtin_amdgcn_s_barrier(); asm volatile("" ::: "memory");
        f32x4 gv[2][2];
#pragma unroll
        for (int bj = 0; bj < 2; ++bj) { gv[bj][0] = *(const f32x4*)(gfin + col0 + bj * 32); gv[bj][1] = *(const f32x4*)(gfin + col0 + bj * 32 + 4); }
#pragma unroll
        for (int ai = 0; ai < 2; ++ai)
#pragma unroll
            for (int m = 0; m < 4; ++m) {
                const int rl = ai * HALF + wr * 64 + m * 16 + fr, row = u.pm * BM + rl;
                const float rs = red[1024 + rl];
                float* xo = xout + (size_t)row * 1024 + col0;
#pragma unroll
                for (int bj = 0; bj < 2; ++bj) { *(f32x4*)(xo + bj * 32) = acc[ai][bj][m][0] * rs * gv[bj][0]; *(f32x4*)(xo + bj * 32 + 4) = acc[ai][bj][m][1] * rs * gv[bj][1]; }
            }
    }
};

struct EpiGateUp {
    static constexpr bool PERM = true;
    bf16_t* act; const float* ss; const float* cw; const float* cb; float* sb; PG8_LAS float* edge;
    __device__ __forceinline__ void operator()(f32x4 (&acc)[2][2][4][2], const Unit& u, int wr, int wc, int fr, int fq) const {
        asm volatile("" : "+v"(fr), "+v"(fq)); asm volatile("" : "+s"(wr), "+s"(wc));
        const int slot0 = wc * 32 + 8 * fq, fcol0 = u.pn * 128 + slot0;
#pragma unroll
        for (int ai = 0; ai < 2; ++ai)
#pragma unroll
            for (int m = 0; m < 4; ++m) {
                const float rs = rstd_of(ss, u.pm * BM + ai * HALF + wr * 64 + m * 16 + fr);
#pragma unroll
                for (int bj = 0; bj < 2; ++bj)
#pragma unroll
                    for (int n = 0; n < 2; ++n) acc[ai][bj][m][n] = acc[ai][bj][m][n] * rs;
            }
        PG8_LAS float* eB = edge + slot0, * eT = edge + 17 * 128 + slot0;
        if (fr == 0 || fr == 15) {
            PG8_LAS float* e0 = (fr == 15 ? eB + 128 : eT) + wr * 4 * 128;
#pragma unroll
            for (int ai = 0; ai < 2; ++ai)
#pragma unroll
                for (int m = 0; m < 4; ++m) { *(PG8_LAS f32x4*)(e0 + (ai * 8 + m) * 128) = acc[ai][0][m][0]; *(PG8_LAS f32x4*)(e0 + (ai * 8 + m) * 128 + 4) = acc[ai][0][m][1]; }
        }
        asm volatile("s_waitcnt lgkmcnt(0)" ::: "memory"); __builtin_amdgcn_s_barrier(); asm volatile("" ::: "memory");
        const PG8_LAS float* rB = eB + wr * 4 * 128, * rT = eT + (wr * 4 + 1) * 128;
        const int rowb = u.pm * BM + wr * 64 + fr;
        u32x2 keep[2][4];
#pragma unroll
        for (int n = 0; n < 2; ++n) {
            const f32x4 w0 = *(const f32x4*)(cw + fcol0 + 4 * n), w1 = *(const f32x4*)(cw + 2816 + fcol0 + 4 * n), w2 = *(const f32x4*)(cw + 5632 + fcol0 + 4 * n), bb = *(const f32x4*)(cb + fcol0 + 4 * n);
#pragma unroll
            for (int ai = 0; ai < 2; ++ai)
#pragma unroll
                for (int m = 0; m < 4; ++m) {
                    const f32x4 ep = *(const PG8_LAS f32x4*)(rB + (ai * 8 + m) * 128 + 4 * n), en = *(const PG8_LAS f32x4*)(rT + (ai * 8 + m) * 128 + 4 * n);
                    f32x4 cv, av;
#pragma unroll
                    for (int e = 0; e < 4; ++e) {
                        const float g = acc[ai][0][m][n][e];
                        const float up = __builtin_bit_cast(float, __builtin_amdgcn_update_dpp(0, __builtin_bit_cast(int, g), 0x111, 0xf, 0xf, true));
                        const float dn = __builtin_bit_cast(float, __builtin_amdgcn_update_dpp(0, __builtin_bit_cast(int, g), 0x101, 0xf, 0xf, true));
                        const float prev = (fr == 0) ? ep[e] : up, next = (fr == 15) ? en[e] : dn;
                        const float c = w0[e] * prev + w1[e] * g + w2[e] * next + bb[e];
                        const float sg = __builtin_amdgcn_rcpf(1.0f + __builtin_amdgcn_exp2f(-1.4426950408889634f * c));
                        cv[e] = c; av[e] = c * sg * acc[ai][1][m][n][e];
                    }
                    const bool seam = (ai == 0 && m == 0) ? (wr == 0 && fr == 0) : ((ai == 1 && m == 3) ? (wr == 1 && fr == 15) : false);
                    if (seam) {
                        float* s = sb + (size_t)((u.pm * 2 + ai) * 3) * 2816 + fcol0 + 4 * n;
                        *(f32x4*)(s) = acc[ai][0][m][n]; *(f32x4*)(s + 2816) = cv; *(f32x4*)(s + 5632) = acc[ai][1][m][n];
                    }
                    {
                        u32x2 w; w.x = cvt_pk_bf16(av[0], av[1]); w.y = cvt_pk_bf16(av[2], av[3]);
                        if (n == 0) keep[ai][m] = w;
                        else if (!seam) { u32x4 w4; w4.x = keep[ai][m].x; w4.y = keep[ai][m].y; w4.z = w.x; w4.w = w.y; *(u32x4*)(act + ilv_off(rowb + ai * HALF + m * 16, fcol0, 2816)) = w4; }
                    }
                }
        }
    }
};

template <class Epi, class Sched, bool ALIGN_EPI = true, bool SP2 = true>
__device__ __forceinline__ void gemm_phase(PG8_LAS unsigned char* lds, const Gemm g, const Sched& S, const Epi& E) {
    int tid = threadIdx.x; asm volatile("" : "+v"(tid));
    const int wid = __builtin_amdgcn_readfirstlane(tid >> 6), lane = tid & 63, wr = wid >> 2, wc = wid & 3, fr = lane & 15, fq = lane >> 4;
    const int K = g.K, nt = K / BK;
    unsigned voffA[2], voffB[2];
#pragma unroll
    for (int i = 0; i < 2; ++i) { int R, C; stage_rc(tid * 16 + i * 8192, R, C); const int Rb = Epi::PERM ? (64 * (R >> 5) + perm32(R & 31)) : R;
        voffA[i] = g.ailv ? (unsigned)ilv_off(R, C, K) * 2u : (unsigned)(R * K + C) * 2u; voffB[i] = (unsigned)(Rb * K + C) * 2u; }
    const size_t kstep = (size_t)(BK * 2), kstepA = g.ailv ? 2 * kstep : kstep;
    const size_t hstepA = (size_t)HALF * K * 2, hstepB = (size_t)32 * K * 2;
    const size_t tstep = 2 * hstepA;
    const unsigned ldsw = (unsigned)wid * 1024u;
    const int aoff = lds_byte(wr * 64 + fr, fq * 8), boff = lds_byte(wc * 32 + fr, fq * 8);
#define PG8_SA(b, h) (((b) * 2 + (h)) * HTB)
#define PG8_SB(b, h) ((4 + (b) * 2 + (h)) * HTB)
#define PG8_STAGE(bufoff, gbase, voff) do { _Pragma("unroll") for (int _i = 0; _i < 2; ++_i) \
        __builtin_amdgcn_global_load_lds((const unsigned*)((const char*)(gbase) + (voff)[_i]), (PG8_LAS unsigned*)(lds + (bufoff) + ldsw + _i * 8192), 16, 0, 0); } while (0)
#define PG8_LDA(dst, b, h) do { _Pragma("unroll") for (int m = 0; m < 4; ++m) _Pragma("unroll") for (int k = 0; k < 2; ++k) dst[m][k] = *(const PG8_LAS bf16x8*)(lds + PG8_SA(b, h) + aoff + m * 2048 + k * 1024); } while (0)
#define PG8_LDB(dst, b, h) do { _Pragma("unroll") for (int n = 0; n < 2; ++n) _Pragma("unroll") for (int k = 0; k < 2; ++k) dst[n][k] = *(const PG8_LAS bf16x8*)(lds + PG8_SB(b, h) + boff + n * 2048 + k * 1024); } while (0)
#define PG8_MMA(ai, bj, At, Bt) do { __builtin_amdgcn_s_setprio(1); _Pragma("unroll") for (int m = 0; m < 4; ++m) _Pragma("unroll") for (int n = 0; n < 2; ++n) _Pragma("unroll") for (int k = 0; k < 2; ++k) \
        acc[ai][bj][m][n] = __builtin_amdgcn_mfma_f32_16x16x32_bf16(Bt[n][k], At[m][k], acc[ai][bj][m][n], 0, 0, 0); __builtin_amdgcn_s_setprio(0); } while (0)
#define PG8_WAIT_V(n) asm volatile("s_waitcnt vmcnt(" #n ")" ::: "memory")
#define PG8_WAIT_L(n) asm volatile("s_waitcnt lgkmcnt(" #n ")" ::: "memory")
#define PG8_BAR __builtin_amdgcn_s_barrier()
#define PG8_SCHED __builtin_amdgcn_sched_barrier(0)
    Unit cur, nxt; int ui = 0;
    if (!S.next(0, cur)) return;
    f32x4 acc[2][2][4][2];
#pragma unroll
    for (int a = 0; a < 2; ++a)
#pragma unroll
        for (int b = 0; b < 2; ++b)
#pragma unroll
            for (int m = 0; m < 4; ++m)
#pragma unroll
                for (int n = 0; n < 2; ++n) acc[a][b][m][n] = (f32x4){0.f, 0.f, 0.f, 0.f};
    bf16x8 At[4][2], B0[2][2], B1[2][2];
    const char* cA = (const char*)g.A + (size_t)cur.pm * tstep; const char* cB = (const char*)g.Bt + (size_t)cur.pn * tstep;
    if constexpr (SP2) {
        PG8_STAGE(PG8_SB(0, 0), cB, voffB); PG8_STAGE(PG8_SB(0, 1), cB + hstepB, voffB); PG8_STAGE(PG8_SA(0, 0), cA, voffA); PG8_STAGE(PG8_SA(0, 1), cA + hstepA, voffA);
        if (wr == 1) PG8_BAR;
        PG8_WAIT_V(2); PG8_BAR;
        PG8_STAGE(PG8_SB(1, 0), cB + kstep, voffB); PG8_STAGE(PG8_SA(1, 0), cA + kstepA, voffA); PG8_STAGE(PG8_SB(1, 1), cB + hstepB + kstep, voffB);
        PG8_WAIT_V(6); PG8_BAR;
    } else {
        PG8_STAGE(PG8_SB(0, 0), cB, voffB); PG8_STAGE(PG8_SA(0, 0), cA, voffA); PG8_STAGE(PG8_SB(0, 1), cB + hstepB, voffB); PG8_STAGE(PG8_SA(0, 1), cA + hstepA, voffA);
        if (wr == 1) PG8_BAR;
        PG8_WAIT_V(4); PG8_BAR;
        PG8_STAGE(PG8_SB(1, 0), cB + kstep, voffB); PG8_STAGE(PG8_SA(1, 0), cA + kstepA, voffA); PG8_STAGE(PG8_SB(1, 1), cB + hstepB + kstep, voffB);
        PG8_WAIT_V(6); PG8_BAR;
    }
    for (;;) {
        const bool has_next = S.next(ui + 1, nxt);
        const char* nA = has_next ? (const char*)g.A + (size_t)nxt.pm * tstep : cA; const char* nB = has_next ? (const char*)g.Bt + (size_t)nxt.pn * tstep : cB;
        for (int t = 0; t < nt; t += 2) {
            const bool last = (t == nt - 2);
            const char* a1 = cA + (size_t)(t + 1) * kstepA;
            const char* a2 = last ? nA : cA + (size_t)(t + 2) * kstepA; const char* b2 = last ? nB : cB + (size_t)(t + 2) * kstep;
            const char* a3 = a2 + kstepA; const char* b3 = b2 + kstep;
            if constexpr (SP2) {
            PG8_LDB(B0, 0, 0); PG8_LDB(B1, 0, 1); PG8_SCHED; PG8_LDA(At, 0, 0); PG8_STAGE(PG8_SA(1, 1), a1 + hstepA, voffA);
            PG8_WAIT_V(8); PG8_WAIT_L(0); PG8_BAR; PG8_MMA(0, 0, At, B0); PG8_MMA(0, 1, At, B1); PG8_BAR; PG8_SCHED;
            PG8_LDA(At, 0, 1); PG8_STAGE(PG8_SB(0, 0), b2, voffB); PG8_STAGE(PG8_SB(0, 1), b2 + hstepB, voffB); PG8_STAGE(PG8_SA(0, 0), a2, voffA);
            PG8_WAIT_V(8); PG8_WAIT_L(0); PG8_BAR; PG8_MMA(1, 0, At, B0); PG8_MMA(1, 1, At, B1); PG8_BAR; PG8_SCHED;
            PG8_LDB(B0, 1, 0); PG8_LDB(B1, 1, 1); PG8_SCHED; PG8_LDA(At, 1, 0); PG8_STAGE(PG8_SA(0, 1), a2 + hstepA, voffA);
            PG8_WAIT_V(8); PG8_WAIT_L(0); PG8_BAR; PG8_MMA(0, 0, At, B0); PG8_MMA(0, 1, At, B1); PG8_BAR; PG8_SCHED;
            PG8_LDA(At, 1, 1); PG8_STAGE(PG8_SB(1, 0), b3, voffB); PG8_STAGE(PG8_SB(1, 1), b3 + hstepB, voffB); PG8_STAGE(PG8_SA(1, 0), a3, voffA);
            PG8_WAIT_V(8); PG8_WAIT_L(0); PG8_BAR; PG8_MMA(1, 0, At, B0); PG8_MMA(1, 1, At, B1); PG8_BAR; PG8_SCHED;
            } else {
            PG8_LDB(B0, 0, 0); PG8_SCHED; PG8_LDA(At, 0, 0); PG8_STAGE(PG8_SA(1, 1), a1 + hstepA, voffA);
            PG8_WAIT_L(8); PG8_BAR; PG8_WAIT_L(0); PG8_MMA(0, 0, At, B0); PG8_BAR; PG8_SCHED;
            PG8_LDB(B1, 0, 1); PG8_STAGE(PG8_SB(0, 0), b2, voffB);
            PG8_BAR; PG8_WAIT_L(0); PG8_MMA(0, 1, At, B1); PG8_BAR;
            PG8_LDA(At, 0, 1); PG8_STAGE(PG8_SA(0, 0), a2, voffA);
            PG8_BAR; PG8_WAIT_L(0); PG8_MMA(1, 0, At, B0); PG8_BAR; PG8_SCHED;
            PG8_STAGE(PG8_SB(0, 1), b2 + hstepB, voffB);
            PG8_WAIT_V(6); PG8_BAR; PG8_MMA(1, 1, At, B1); PG8_BAR;
            PG8_LDB(B0, 1, 0); PG8_SCHED; PG8_LDA(At, 1, 0); PG8_STAGE(PG8_SA(0, 1), a2 + hstepA, voffA);
            PG8_WAIT_L(8); PG8_BAR; PG8_WAIT_L(0); PG8_MMA(0, 0, At, B0); PG8_BAR; PG8_SCHED;
            PG8_LDB(B1, 1, 1); PG8_STAGE(PG8_SB(1, 0), b3, voffB);
            PG8_BAR; PG8_WAIT_L(0); PG8_MMA(0, 1, At, B1); PG8_BAR;
            PG8_LDA(At, 1, 1); PG8_STAGE(PG8_SA(1, 0), a3, voffA);
            PG8_BAR; PG8_WAIT_L(0); PG8_MMA(1, 0, At, B0); PG8_BAR; PG8_SCHED;
            PG8_STAGE(PG8_SB(1, 1), b3 + hstepB, voffB);
            PG8_WAIT_V(6); PG8_BAR; PG8_MMA(1, 1, At, B1); PG8_BAR;
            }
        }
        if constexpr (ALIGN_EPI) { if (wr == 0) PG8_BAR; }
        E(acc, cur, wr, wc, fr, fq);
        if (!has_next) break;
#pragma unroll
        for (int a = 0; a < 2; ++a)
#pragma unroll
            for (int b = 0; b < 2; ++b)
#pragma unroll
                for (int m = 0; m < 4; ++m)
#pragma unroll
                    for (int n = 0; n < 2; ++n) acc[a][b][m][n] = (f32x4){0.f, 0.f, 0.f, 0.f};
        cur = nxt; cA = nA; cB = nB; ++ui;
        if constexpr (ALIGN_EPI) { if (wr == 1) PG8_BAR; }
    }
    PG8_WAIT_V(0);
    if constexpr (!ALIGN_EPI) { if (wr == 0) PG8_BAR; }
    PG8_BAR;
#undef PG8_SA
#undef PG8_SB
#undef PG8_STAGE
#undef PG8_LDA
#undef PG8_LDB
#undef PG8_MMA
#undef PG8_WAIT_V
#undef PG8_WAIT_L
#undef PG8_BAR
#undef PG8_SCHED
}
}

#define LAS __attribute__((address_space(3)))
#define CAS __attribute__((address_space(4)))
typedef unsigned short bf16;
typedef float f32x4 __attribute__((ext_vector_type(4)));
typedef float f32x16 __attribute__((ext_vector_type(16)));
typedef short bf16x8 __attribute__((ext_vector_type(8)));
typedef short s16x4 __attribute__((ext_vector_type(4)));
typedef unsigned u32x4 __attribute__((ext_vector_type(4)));
typedef unsigned u32x2 __attribute__((ext_vector_type(2)));

constexpr int D = 1024, MTOK = 81920, MPROMPT = 65536, MMEM = 8448, FF = 2816;
constexpr int NTILE = MTOK / 256;
constexpr size_t MiB = 1u << 20;
constexpr size_t WS_CTL = 0, CTL_ZERO_BYTES = 131072;
constexpr int CW_PANEL = 4096;
constexpr size_t WS_XS = 110 * MiB + 768 * 1024;
constexpr size_t WS_WINA = 1 * MiB, WS_WINB = 4 * MiB, WS_WMKV = 9 * MiB, WS_WO = 11 * MiB, WS_WGU = 15 * MiB, WS_WD = 37 * MiB;
constexpr size_t WS_SS = 49 * MiB, WS_SSM = 55 * MiB, WS_MB = 56 * MiB, WS_MKV = 73 * MiB, WS_SB = 90 * MiB;
constexpr size_t WS_XB = 112 * MiB, WS_PROJ = 272 * MiB, WS_O = 672 * MiB, WS_ACT = 272 * MiB, WS_END = 832 * MiB;
static_assert(WS_WINA + (size_t)1536 * 1024 * 2 <= WS_WINB && WS_WINB + (size_t)2560 * 1024 * 2 <= WS_WMKV && WS_WMKV + (size_t)1024 * 1024 * 2 <= WS_WO && WS_WO + (size_t)2 * 1024 * 1024 * 2 <= WS_WGU &&
              WS_WGU + (size_t)2 * 5632 * 1024 * 2 <= WS_WD && WS_WD + (size_t)2 * 1024 * 2816 * 2 <= WS_SS && WS_SS + (size_t)MTOK * 16 <= WS_SSM && WS_SSM + (size_t)MMEM * 16 <= WS_MB &&
              WS_MB + (size_t)MMEM * 1024 * 2 <= WS_MKV && WS_MKV + (size_t)MMEM * 1024 * 2 <= WS_SB && WS_SB + (size_t)NTILE * 6 * FF * 4 <= WS_XB && WS_XB + (size_t)MTOK * 1024 * 2 <= WS_PROJ &&
              WS_PROJ + (size_t)MTOK * 2560 * 2 <= WS_O && WS_O + (size_t)MTOK * 1024 * 2 <= WS_END && WS_ACT + (size_t)MTOK * FF * 2 <= WS_END, "d_ws map");

static_assert((CW_PANEL + 64 * 320) * 4 <= (int)CTL_ZERO_BYTES && WS_SB + (size_t)NTILE * 6 * FF * 4 <= WS_XS && WS_XS + (size_t)320 * 4 * 256 * 4 <= WS_XB, "ctl / exchange map");
constexpr int LDS_X_OFF = 131072;
constexpr int MISC_OFF = 131072 + 2 * 17 * 128 * 4 + 512;
constexpr int LDS_BYTES = 131072 + 2 * 17 * 128 * 4 + 1024;
constexpr int NWAVES = 8;

__device__ __forceinline__ unsigned f2bf(float f) { unsigned u = __builtin_bit_cast(unsigned, f); return (u + 0x7fffu + ((u >> 16) & 1u)) >> 16; }
__device__ __forceinline__ unsigned pk2(float lo, float hi) { return f2bf(lo) | (f2bf(hi) << 16); }
__device__ __forceinline__ float wave_sum(float v) {
#pragma unroll
    for (int o = 1; o < 64; o <<= 1) v += __shfl_xor(v, o);
    return v;
}

#define XB_TMO      128
#define XB_XCNT(j)  (256  + 64 * (j))
#define XB_XSUB(j)  (1280 + 64 * (j))
#define XB_XGEN(j)  (2304 + 64 * (j))
#define XB_TOP      3328
#define XB_TOPGEN   3392
#define XCD_BAR_WORDS 3456
#define XB_SPIN_CAP (1u << 22)
__device__ __forceinline__ unsigned xb_ld(unsigned* p)              { return __hip_atomic_load(p, __ATOMIC_RELAXED, __HIP_MEMORY_SCOPE_AGENT); }
__device__ __forceinline__ unsigned xb_add(unsigned* p, unsigned v) { return __hip_atomic_fetch_add(p, v, __ATOMIC_RELAXED, __HIP_MEMORY_SCOPE_AGENT); }
__device__ __forceinline__ unsigned xb_xcc_id() { return (unsigned)__builtin_amdgcn_s_getreg((3 << 11) | 20) & 0xFu; }
#define XB_SPIN(cond, bar) do { unsigned _sp = 0; while (cond) { __builtin_amdgcn_s_sleep(1); \
    if ((++_sp & 255u) == 0u) { if (xb_ld(&(bar)[XB_TMO])) break; if (_sp > XB_SPIN_CAP) { atomicAdd(&(bar)[XB_TMO], 1u); break; } } } } while (0)
__device__ __forceinline__ void xcd_barrier_complete(unsigned* bar, unsigned x, unsigned& nloc, unsigned& nx) {
    const unsigned G = gridDim.x * gridDim.y * gridDim.z;
    unsigned sum, cnt, mine, sp = 0u;
    for (;;) {
        sum = 0u; cnt = 0u; mine = 0u;
#pragma unroll
        for (unsigned j = 0; j < 16; ++j) { const unsigned c = xb_ld(&bar[XB_XCNT(j)]); sum += c; cnt += (c > 0u) ? 1u : 0u; mine = (j == x) ? c : mine; }
        if (sum == G) break;
        __builtin_amdgcn_s_sleep(1);
        if ((++sp & 255u) == 0u) { if (xb_ld(&bar[XB_TMO])) break; if (sp > XB_SPIN_CAP) { atomicAdd(&bar[XB_TMO], 1u); break; } }
    }
    nloc = mine > 0u ? mine : 1u; nx = cnt > 0u ? cnt : 1u;
}
__device__ __forceinline__ void xcd_barrier(unsigned* bar, volatile __attribute__((address_space(3))) unsigned* st) {
    asm volatile("s_waitcnt vmcnt(0)" ::: "memory");
    __syncthreads();
    if (threadIdx.x == 0) {
        const unsigned x = xb_xcc_id();
        __builtin_amdgcn_s_waitcnt(0);
        unsigned nloc = st[0], nx = st[1];
        if (nloc == 0u) { xcd_barrier_complete(bar, x, nloc, nx); st[0] = nloc; st[1] = nx; }
        const unsigned old = xb_add(&bar[XB_XSUB(x)], 1u);
        const unsigned gen = old / nloc;
        if (old + 1u == (gen + 1u) * nloc) {
            __builtin_amdgcn_fence(__ATOMIC_RELEASE, "agent");
            asm volatile("s_waitcnt vmcnt(0)" ::: "memory");
            const unsigned og = xb_add(&bar[XB_TOP], 1u);
            const unsigned tg = og / nx;
            if (og + 1u == (tg + 1u) * nx) xb_add(&bar[XB_TOPGEN], 1u);
            else XB_SPIN(xb_ld(&bar[XB_TOPGEN]) == tg, bar);
            __builtin_amdgcn_fence(__ATOMIC_ACQUIRE, "agent");
            xb_add(&bar[XB_XGEN(x)], 1u);
            asm volatile("s_waitcnt vmcnt(0)" ::: "memory");
        } else {
            XB_SPIN(xb_ld(&bar[XB_XGEN(x)]) == gen, bar);
            __builtin_amdgcn_fence(__ATOMIC_ACQUIRE, "agent");
            asm volatile("s_waitcnt vmcnt(0)" ::: "memory");
        }
    }
    __syncthreads();
}

__device__ __forceinline__ void p0_transpose_item(const float* W, int K, int N, bf16* WT, int row_off, int mode, const float* gain, LAS float* scr, int item, int lane) {
    const int nblk = N / 32, kb = item / nblk, nb = item % nblk, k0 = 64 * kb, n0 = 32 * nb;
#pragma unroll 8
    for (int i = 0; i < 32; ++i) { const int kk = 2 * i + (lane >> 5); float v = W[(size_t)(k0 + kk) * N + n0 + (lane & 31)]; if (gain) v *= gain[k0 + kk]; scr[kk * 33 + (lane & 31)] = v; }
    asm volatile("s_waitcnt lgkmcnt(0)" ::: "memory");
    const int c = lane & 7;
    const int drow0 = (mode == 0) ? row_off + n0 : (n0 / 128) * 256 + ((n0 % 128) / 32) * 64 + (mode - 1) * 32;
#pragma unroll
    for (int j = 0; j < 4; ++j) { const int n = (lane >> 3) + 8 * j; const LAS float* s = scr + (8 * c) * 33 + n;
        u32x4 o; o.x = pk2(s[0 * 33], s[1 * 33]); o.y = pk2(s[2 * 33], s[3 * 33]); o.z = pk2(s[4 * 33], s[5 * 33]); o.w = pk2(s[6 * 33], s[7 * 33]);
        *(u32x4*)(WT + (size_t)(drow0 + n) * K + k0 + 8 * c) = o; }
    asm volatile("s_waitcnt lgkmcnt(0)" ::: "memory");
}
__device__ __forceinline__ void row_to_bf16(const float* xrow, bf16* orow, float* ssrow, int lane) {
    const f32x4* xr = (const f32x4*)xrow + lane;
    f32x4 v[4]; float s = 0.f;
#pragma unroll
    for (int j = 0; j < 4; ++j) { v[j] = xr[64 * j]; s += (v[j].x * v[j].x + v[j].y * v[j].y) + (v[j].z * v[j].z + v[j].w * v[j].w); }
    s = wave_sum(s);
    u32x2* o8 = (u32x2*)orow + lane;
#pragma unroll
    for (int j = 0; j < 4; ++j) { u32x2 w; w.x = pk2(v[j].x, v[j].y); w.y = pk2(v[j].z, v[j].w); o8[64 * j] = w; }
    if (lane == 0) *(f32x4*)ssrow = (f32x4){s, 0.f, 0.f, 0.f};
}

struct Args {
    const float* in[19]; float* out; unsigned char* ws; int ph_lo, ph_hi;
};

constexpr float LOG2E = 1.4426950408889634f;
constexpr float CSC = 0.125f * LOG2E;
#define MFMA32(a, b, c) __builtin_amdgcn_mfma_f32_32x32x16_bf16((a), (b), (c), 0, 0, 0)
__device__ __forceinline__ int crow(int i, int hi) { return (i & 3) + 8 * (i >> 2) + 4 * hi; }

template <int UN> struct VRegs { u32x4 a[UN], b[UN]; };
template <int UN> __device__ __forceinline__ void vt_load(VRegs<UN>& R, const bf16* Vbase, int pitch, int gk0, int kl_lo, int kl_hi) {
    const int npair = (kl_hi - kl_lo) >> 1, total = npair * 8;
#pragma unroll
    for (int uu = 0; uu < UN; ++uu) {
        const int idx = threadIdx.x + uu * NWAVES * 64;
        if (idx < total) {
            const int c = idx / npair, p = idx - c * npair, kl = kl_lo + 2 * p;
            const bf16* src = Vbase + (size_t)(gk0 + kl) * pitch + 8 * c;
            R.a[uu] = *(const u32x4*)src; R.b[uu] = *(const u32x4*)(src + pitch);
        }
    }
}
template <int UN> __device__ __forceinline__ void vt_store(const VRegs<UN>& R, LAS unsigned char* vt, int VS, int kl_lo, int kl_hi) {
    const int npair = (kl_hi - kl_lo) >> 1, total = npair * 8, rs = VS / 2;
#pragma unroll
    for (int uu = 0; uu < UN; ++uu) {
        const int idx = threadIdx.x + uu * NWAVES * 64;
        if (idx < total) {
            const int c = idx / npair, p = idx - c * npair, kl = kl_lo + 2 * p;
            LAS unsigned* dst = (LAS unsigned*)(vt + ((size_t)(8 * c) * VS + kl) * 2);
#pragma unroll
            for (int i = 0; i < 4; ++i) {
                dst[(2 * i) * rs] = (R.a[uu][i] & 0xffffu) | (R.b[uu][i] << 16);
                dst[(2 * i + 1) * rs] = (R.a[uu][i] >> 16) | (R.b[uu][i] & 0xffff0000u);
            }
        }
    }
}
template <int UN> struct KRegs { u32x4 a[UN]; };
template <int UN> __device__ __forceinline__ void kt_load(KRegs<UN>& R, const bf16* Kbase, int pitch, int gk0, int kl_lo, int kl_hi) {
    const int total = (kl_hi - kl_lo) * 8;
#pragma unroll
    for (int uu = 0; uu < UN; ++uu) {
        const int idx = threadIdx.x + uu * NWAVES * 64;
        if (idx < total) { const int kl = kl_lo + (idx >> 3), c = idx & 7; R.a[uu] = *(const u32x4*)(Kbase + (size_t)(gk0 + kl) * pitch + 8 * c); }
    }
}
template <int UN> __device__ __forceinline__ void kt_store(const KRegs<UN>& R, LAS unsigned char* kt, int kl_lo, int kl_hi) {
    const int total = (kl_hi - kl_lo) * 8;
#pragma unroll
    for (int uu = 0; uu < UN; ++uu) {
        const int idx = threadIdx.x + uu * NWAVES * 64;
        if (idx < total) { const int kl = kl_lo + (idx >> 3), c = idx & 7; *(LAS u32x4*)(kt + kl * 128 + ((c ^ ((kl >> 1) & 7)) << 4)) = R.a[uu]; }
    }
}
__device__ __forceinline__ void load_kfrag_lds(bf16x8 (&f)[4], const LAS unsigned char* kt, int kl  , int hi) {
    const LAS unsigned char* p = kt + kl * 128; const int sw = (kl >> 1) & 7;
#pragma unroll
    for (int ks = 0; ks < 4; ++ks) f[ks] = *(const LAS bf16x8*)(p + (((2 * ks + hi) ^ sw) << 4));
}
__device__ __forceinline__ void load_frag4(bf16x8 (&f)[4], const bf16* p) {
#pragma unroll
    for (int ks = 0; ks < 4; ++ks) f[ks] = *(const bf16x8*)(p + 16 * ks);
}
__device__ __forceinline__ void attn_step(f32x16& s, float& m, float& l, f32x16 (&o)[2], const LAS unsigned char* vt, int VSb, int kb0, int lane) {
    float mxa = fmaxf(fmaxf(s[0], s[1]), s[2]), mxb = fmaxf(fmaxf(s[3], s[4]), s[5]);
    mxa = fmaxf(fmaxf(mxa, s[6]), s[7]); mxb = fmaxf(fmaxf(mxb, s[8]), s[9]); mxa = fmaxf(fmaxf(mxa, s[10]), s[11]); mxb = fmaxf(fmaxf(mxb, s[12]), s[13]); mxa = fmaxf(fmaxf(mxa, s[14]), s[15]);
    float mx = fmaxf(mxa, mxb);
    mx = fmaxf(mx, __shfl_xor(mx, 32));
    if (__any(mx > m + 8.0f)) {
        const float mn = fmaxf(m, mx);
        const float corr = __builtin_amdgcn_exp2f(m - mn);
        m = mn; l = l * corr;
#pragma unroll
        for (int d = 0; d < 2; ++d) o[d] = o[d] * corr;
    }
    float sum = 0.f;
#pragma unroll
    for (int i = 0; i < 16; ++i) { s[i] = __builtin_amdgcn_exp2f(s[i] - m); sum += s[i]; }
    sum += __shfl_xor(sum, 32);
    l = l + sum;
    bf16x8 pb[2];
#pragma unroll
    for (int st = 0; st < 2; ++st) {
        u32x4 w; w.x = pg8::cvt_pk_bf16(s[8 * st + 0], s[8 * st + 1]); w.y = pg8::cvt_pk_bf16(s[8 * st + 2], s[8 * st + 3]); w.z = pg8::cvt_pk_bf16(s[8 * st + 4], s[8 * st + 5]); w.w = pg8::cvt_pk_bf16(s[8 * st + 6], s[8 * st + 7]);
        pb[st] = __builtin_bit_cast(bf16x8, w);
    }
    const int dl = lane & 31, hi = lane >> 5;
#pragma unroll
    for (int db = 0; db < 2; ++db)
#pragma unroll
        for (int st = 0; st < 2; ++st) {
            const LAS unsigned char* p = vt + (size_t)(32 * db + dl) * VSb + (size_t)(kb0 + 16 * st + 4 * hi) * 2;
            const s16x4 a0 = *(const LAS s16x4*)p, a1 = *(const LAS s16x4*)(p + 16);
            const bf16x8 a = __builtin_shufflevector(a0, a1, 0, 1, 2, 3, 4, 5, 6, 7);
            o[db] = MFMA32(a, pb[st], o[db]);
        }
}
__device__ __forceinline__ void store_o(const f32x16 (&o)[2], float l, bf16* orow, int hi) {
    const float inv = 1.0f / l;
#pragma unroll
    for (int db = 0; db < 2; ++db)
#pragma unroll
        for (int ig = 0; ig < 4; ++ig) {
            u32x2 w; w.x = pg8::cvt_pk_bf16(o[db][4 * ig] * inv, o[db][4 * ig + 1] * inv); w.y = pg8::cvt_pk_bf16(o[db][4 * ig + 2] * inv, o[db][4 * ig + 3] * inv);
            *(u32x2*)(orow + 32 * db + 8 * ig + 4 * hi) = w;
        }
}
__device__ __forceinline__ void tile_seq(int pm, int& seq, int& jb, int& T, int& seqbase) {
    if (pm < 256) { seq = pm >> 3; jb = pm & 7; T = 2048; seqbase = seq * 2048; } else { seq = 32; jb = pm - 256; T = 16384; seqbase = MPROMPT; }
}

__device__ __forceinline__ void window_chunk(const LAS unsigned char* vt, int VSb, const LAS unsigned char* kt, const bf16x8 (&qf)[4], bf16* O, int seqbase, int T, int jb, int g, int r, int qc, float sink, int lane) {
    const int q = lane & 31, hi = lane >> 5, hq = 3 * g + r, t0 = 256 * jb + 32 * qc, t = t0 + q;
    const float slope2 = exp2f(-8.0f * (float)(hq + 1) / 12.0f) * LOG2E;
    float m = sink * LOG2E, l = 1.0f;
    f32x16 o[2];
#pragma unroll
    for (int i = 0; i < 16; ++i) { o[0][i] = 0.f; o[1][i] = 0.f; }
    const int kb_lo = (t0 / 32 - 4) > 0 ? (t0 / 32 - 4) : 0, kb_hi = (t0 / 32 + 4) < (T / 32 - 1) ? (t0 / 32 + 4) : (T / 32 - 1);
    for (int kb = kb_lo; kb <= kb_hi; ++kb) {
        const int kbl = 32 * kb - 256 * jb + 128;
        bf16x8 kf[4]; load_kfrag_lds(kf, kt, kbl + q, hi);
        f32x16 s;
#pragma unroll
        for (int i = 0; i < 16; ++i) s[i] = 0.f;
#pragma unroll
        for (int ks = 0; ks < 4; ++ks) s = MFMA32(kf[ks], qf[ks], s);
        const float base = (float)(t - 32 * kb - 4 * hi);
#pragma unroll
        for (int i = 0; i < 16; ++i) { const float d = base - (float)((i & 3) + 8 * (i >> 2)); s[i] = fmaf(s[i], CSC, -slope2 * fabsf(d)); }
        if (kb == t0 / 32 - 4 || kb == t0 / 32 + 4) {
#pragma unroll
            for (int i = 0; i < 16; ++i) { const float d = base - (float)((i & 3) + 8 * (i >> 2)); if (fabsf(d) > 128.0f) s[i] = -INFINITY; }
        }
        attn_step(s, m, l, o, vt, VSb, kbl, lane);
    }
    store_o(o, l, O + (size_t)(seqbase + t) * 1024 + hq * 64, hi);
}
__device__ __forceinline__ void mem_chunk(const LAS unsigned char* vt, int VSb, const LAS unsigned char* kt, const bf16x8 (&qf)[4], bf16* obase, int row0, int lane) {
    const int q = lane & 31, hi = lane >> 5;
    float m = -1e30f, l = 0.f;
    f32x16 o[2];
#pragma unroll
    for (int i = 0; i < 16; ++i) { o[0][i] = 0.f; o[1][i] = 0.f; }
    for (int kb = 0; kb < 8; ++kb) {
        bf16x8 kf[4]; load_kfrag_lds(kf, kt, 32 * kb + q, hi);
        f32x16 s;
#pragma unroll
        for (int i = 0; i < 16; ++i) s[i] = 0.f;
#pragma unroll
        for (int ks = 0; ks < 4; ++ks) s = MFMA32(kf[ks], qf[ks], s);
#pragma unroll
        for (int i = 0; i < 16; ++i) s[i] = s[i] * CSC;
        attn_step(s, m, l, o, vt, VSb, 32 * kb, lane);
    }
    store_o(o, l, obase + (size_t)(row0 + q) * 1024, hi);
}
__device__ __forceinline__ void na_chunk(const LAS unsigned char* vt, int VSb, const LAS float* rpbL, const bf16* kptr  , bf16* optr  ,
                                         const bf16x8 (&qf)[4], bf16x8 (&kf)[4], bf16x8 (&kf1)[4], int row_q, int c, int col0, int r0q, int kr_lo, int kr_hi, int klo, int lane) {
    const int hi = lane >> 5;
    int c0 = c - 8; c0 = c0 < 0 ? 0 : c0; c0 = c0 > 48 ? 48 : c0;
    float m = -1e30f, l = 0.f;
    f32x16 o[2];
#pragma unroll
    for (int i = 0; i < 16; ++i) { o[0][i] = 0.f; o[1][i] = 0.f; }
    int dcc[16];
#pragma unroll
    for (int ii = 0; ii < 16; ++ii) { const int kc = col0 + crow(ii, hi); dcc[ii] = ((unsigned)(kc - c0) < 16u) ? (kc - c + 15) : 31; }
    bf16x8 kn[4];
#define NA_BLOCK(KF) do { \
        f32x16 s; \
        _Pragma("unroll") for (int ii = 0; ii < 16; ++ii) s[ii] = 0.f; \
        _Pragma("unroll") for (int ks = 0; ks < 4; ++ks) s = MFMA32(KF[ks], qf[ks], s); \
        const int br = ((unsigned)(kr - r0q) < 8u) ? (kr - row_q + 7) : 15;     \
        const LAS float* brow = rpbL + br * 32; \
        _Pragma("unroll") for (int ii = 0; ii < 16; ++ii) s[ii] = fmaf(s[ii], CSC, brow[dcc[ii]]); \
        attn_step(s, m, l, o, vt, VSb, (kr - klo) * 64 + col0, lane); } while (0)
#define NA_LOAD(KF) do { if (kr + 2 <= kr_hi) load_frag4(KF, kptr + (size_t)(kr + 2 - kr_lo) * 64 * 2560); } while (0)
    for (int kr = kr_lo;;) {
        NA_LOAD(kn);  NA_BLOCK(kf);  if (++kr > kr_hi) break;
        NA_LOAD(kf);  NA_BLOCK(kf1); if (++kr > kr_hi) break;
        NA_LOAD(kf1); NA_BLOCK(kn);  if (++kr > kr_hi) break;
    }
#undef NA_BLOCK
#undef NA_LOAD
    store_o(o, l, optr, hi);
}

#define LDS_BARRIER() do { asm volatile("s_waitcnt lgkmcnt(0)" ::: "memory"); __builtin_amdgcn_s_barrier(); asm volatile("" ::: "memory"); } while (0)
constexpr int MEM_KT_OFF = 34816;
__device__ __forceinline__ void mem_units(LAS unsigned char* lds, const bf16* proj, int qpitch, int qcol, const bf16* mkv, int layer, bf16* O, int wave, int lane, int vcu) {
    const int N = NTILE * 4, G = gridDim.x;
    VRegs<2> VR; KRegs<4> KR; bf16x8 qn[4];
    const int ql = (lane & 31), qh = 8 * (lane >> 5);
    if (vcu < N) { const int hm = vcu / NTILE, pm = vcu - hm * NTILE; int seq, jb, T, seqbase; tile_seq(pm, seq, jb, T, seqbase);
        vt_load<2>(VR, mkv + layer * 512 + 256 + hm * 64, 1024, seq * 256, 0, 256); kt_load<4>(KR, mkv + layer * 512 + hm * 64, 1024, seq * 256, 0, 256);
        load_frag4(qn, proj + qcol + hm * 64 + (size_t)(pm * 256 + 32 * wave + ql) * qpitch + qh); }
    for (int u = vcu; u < N; u += G) {
        const int hm = u / NTILE, pm = u - hm * NTILE; int seq, jb, T, seqbase; tile_seq(pm, seq, jb, T, seqbase);
        bf16x8 qf[4];
#pragma unroll
        for (int ks = 0; ks < 4; ++ks) qf[ks] = qn[ks];
        LDS_BARRIER();
        vt_store<2>(VR, lds, 260, 0, 256); kt_store<4>(KR, lds + MEM_KT_OFF, 0, 256);
        LDS_BARRIER();
        const int un = u + G;
        if (un < N) { const int hm2 = un / NTILE, pm2 = un - hm2 * NTILE; int seq2, jb2, T2, sb2; tile_seq(pm2, seq2, jb2, T2, sb2);
            vt_load<2>(VR, mkv + layer * 512 + 256 + hm2 * 64, 1024, seq2 * 256, 0, 256); kt_load<4>(KR, mkv + layer * 512 + hm2 * 64, 1024, seq2 * 256, 0, 256);
            load_frag4(qn, proj + qcol + hm2 * 64 + (size_t)(pm2 * 256 + 32 * wave + ql) * qpitch + qh); }
        mem_chunk(lds, 260 * 2, lds + MEM_KT_OFF, qf, O + 768 + hm * 64, pm * 256 + 32 * wave, lane);
    }
}

#define LOAD_ARGS() \
    const CAS Args* ap_ = (const CAS Args*)__builtin_amdgcn_kernarg_segment_ptr(); asm volatile("" : "+s"(ap_)); \
    unsigned char* ws = ap_->ws; float* out = ap_->out; (void)out; \
    bf16* WinA = (bf16*)(ws + WS_WINA); bf16* WinB = (bf16*)(ws + WS_WINB); bf16* Wmkv = (bf16*)(ws + WS_WMKV); bf16* Wo = (bf16*)(ws + WS_WO); bf16* Wgu = (bf16*)(ws + WS_WGU); bf16* Wd = (bf16*)(ws + WS_WD); \
    float* SS = (float*)(ws + WS_SS); float* SSM = (float*)(ws + WS_SSM); bf16* MB = (bf16*)(ws + WS_MB); bf16* MKV = (bf16*)(ws + WS_MKV); float* SB = (float*)(ws + WS_SB); \
    bf16* XB = (bf16*)(ws + WS_XB); bf16* PROJ = (bf16*)(ws + WS_PROJ); bf16* OB = (bf16*)(ws + WS_O); bf16* ACT = (bf16*)(ws + WS_ACT); \
    (void)WinA; (void)WinB; (void)Wmkv; (void)Wo; (void)Wgu; (void)Wd; (void)SS; (void)SSM; (void)MB; (void)MKV; (void)SB; (void)XB; (void)PROJ; (void)OB; (void)ACT;
#define ARG(k) (ap_->in[k])
template <int layer>
__device__ __forceinline__ void layer_phases(LAS unsigned char* lds, LAS float* ldsx, const int lo, const int hi_ph, const int G, const int bx) {
    int tid = threadIdx.x; asm volatile("" : "+v"(tid));
    const int lane = tid & 63, wave = __builtin_amdgcn_readfirstlane(tid >> 6);
#define IN(k) (lo <= (k) && (k) < hi_ph)
#define SEAM(k) do { if (IN(k) && IN((k) + 1)) { if ((k) == 0) cg::this_grid().sync(); else { const CAS Args* apb_ = (const CAS Args*)__builtin_amdgcn_kernarg_segment_ptr(); asm volatile("" : "+s"(apb_)); xcd_barrier((unsigned*)(apb_->ws + WS_CTL), (volatile LAS unsigned*)(lds + MISC_OFF)); } } } while (0)
        const int pb = 1 + 6 * layer;
        const int NP = layer == 0 ? 1536 : 2560;
        if (IN(pb)) {
            LOAD_ARGS();
            for (int rep = 0; rep < NREP(1); ++rep)
            { pg8::Gemm g{XB, layer == 0 ? WinA : WinB, MTOK, NP, D, 0}; pg8::StaticOrder S; S.init(MTOK, NP, G, bx);
              pg8::EpiScaleBf16 E{PROJ, NP, SS};
              pg8::gemm_phase<pg8::EpiScaleBf16, pg8::StaticOrder>(lds, g, S, E); }
            { pg8::Gemm g{MB, Wmkv + (size_t)layer * 512 * 1024, MMEM, 512, D, 0}; pg8::StaticOrder S; S.init(MMEM, 512, G, (bx + G / 2) % G);
              pg8::EpiScaleBf16 E{MKV + layer * 512, 1024, SSM};
              pg8::gemm_phase<pg8::EpiScaleBf16, pg8::StaticOrder>(lds, g, S, E); }
        }
        SEAM(pb);
        if (IN(pb + 1)) {
            LOAD_ARGS();
            const float* sink_a = ARG(7); const float* rpb_b = ARG(9);
            const int vcu = (G % 8 == 0) ? (bx % 8) * (G / 8) + bx / 8 : bx;
            if (layer == 0) {
                {
                    const int N = NTILE * 4;
                    VRegs<4> VR; KRegs<8> KR; bf16x8 qn[4]; LAS unsigned char* ktw = lds + 69632;
                    if (vcu < N) { const int g = vcu / NTILE, pm = vcu - g * NTILE; int seq, jb, T, seqbase; tile_seq(pm, seq, jb, T, seqbase);
                        const int kl_lo = (jb == 0) ? 128 : 0; int kl_hi = T - 256 * jb + 128; kl_hi = kl_hi > 512 ? 512 : kl_hi;
                        vt_load<4>(VR, PROJ + 1024 + g * 64, 1536, seqbase + 256 * jb - 128, kl_lo, kl_hi); kt_load<8>(KR, PROJ + 768 + g * 64, 1536, seqbase + 256 * jb - 128, kl_lo, kl_hi);
                        { const int c0_ = 3 * wave, r0_ = c0_ >> 3, qc0_ = c0_ & 7; load_frag4(qn, PROJ + (size_t)(seqbase + 256 * jb + 32 * qc0_ + (lane & 31)) * 1536 + (3 * g + r0_) * 64 + 8 * (lane >> 5)); } }
                    for (int u = vcu; u < N; u += G) {
                        const int g = u / NTILE, pm = u - g * NTILE; int seq, jb, T, seqbase; tile_seq(pm, seq, jb, T, seqbase);
                        const int kl_lo = (jb == 0) ? 128 : 0; int kl_hi = T - 256 * jb + 128; kl_hi = kl_hi > 512 ? 512 : kl_hi;
                        LDS_BARRIER();
                        vt_store<4>(VR, lds, 516, kl_lo, kl_hi); kt_store<8>(KR, ktw, kl_lo, kl_hi);
                        LDS_BARRIER();
                        const int un = u + G;
                        if (un < N) { const int g2 = un / NTILE, pm2 = un - g2 * NTILE; int seq2, jb2, T2, sb2; tile_seq(pm2, seq2, jb2, T2, sb2);
                            const int kl_lo2 = (jb2 == 0) ? 128 : 0; int kl_hi2 = T2 - 256 * jb2 + 128; kl_hi2 = kl_hi2 > 512 ? 512 : kl_hi2;
                            vt_load<4>(VR, PROJ + 1024 + g2 * 64, 1536, sb2 + 256 * jb2 - 128, kl_lo2, kl_hi2); kt_load<8>(KR, PROJ + 768 + g2 * 64, 1536, sb2 + 256 * jb2 - 128, kl_lo2, kl_hi2); }
#pragma unroll 1
                        for (int i = 0; i < 3; ++i) { const int cidx = 3 * wave + i, r = cidx >> 3, qc = cidx & 7;
                            bf16x8 qf[4];
#pragma unroll
                            for (int ks = 0; ks < 4; ++ks) qf[ks] = qn[ks];
                            {
                                int u2 = u, i2 = i + 1; if (i2 == 3) { i2 = 0; u2 = u + G; }
                                if (u2 < N) { const int g2 = u2 / NTILE, pm2 = u2 - g2 * NTILE; int seq2, jb2, T2, sb2; tile_seq(pm2, seq2, jb2, T2, sb2);
                                    const int c2 = 3 * wave + i2, r2 = c2 >> 3, qc2 = c2 & 7;
                                    load_frag4(qn, PROJ + (size_t)(sb2 + 256 * jb2 + 32 * qc2 + (lane & 31)) * 1536 + (3 * g2 + r2) * 64 + 8 * (lane >> 5)); }
                            }
                            window_chunk(lds, 516 * 2, ktw, qf, OB, seqbase, T, jb, g, r, qc, sink_a[3 * g + r], lane); }
                    }
                }
                mem_units(lds, PROJ, 1536, 1280, MKV, 0, OB, wave, lane, vcu);
            } else {
                LAS float* rpbL = (LAS float*)(lds + 98304);
                {
                    const int N = NTILE * 12;
                    VRegs<6> VR; float rpbv = 0.f; bf16x8 qn[4], kn0[4];
#define NA_QK(uu_) { NA_DESC(uu_, hq_, jbq_, sbq_, rowsq_, kloq_, khiq_); (void)kloq_; (void)khiq_; const int rpq_ = wave >> 2, aq_ = wave & 3, qq_ = lane & 31, hiq_ = lane >> 5; \
                        const int rAq_ = 4 * jbq_ + 2 * rpq_, rowq_ = rAq_ + (qq_ >> 4), cq_ = 16 * aq_ + (qq_ & 15); int col0q_ = 16 * aq_ - 8; col0q_ = col0q_ < 0 ? 0 : col0q_; col0q_ = col0q_ > 32 ? 32 : col0q_; \
                        int krq_ = rAq_ - 4; krq_ = krq_ < 0 ? 0 : krq_; krq_ = krq_ > rowsq_ - 8 ? rowsq_ - 8 : krq_; \
                        const bf16* kpq_ = PROJ + 768 + hq_ * 64 + 8 * hiq_ + (size_t)(sbq_ + krq_ * 64 + col0q_ + qq_) * 2560; \
                        load_frag4(qn, PROJ + (size_t)(sbq_ + rowq_ * 64 + cq_) * 2560 + hq_ * 64 + 8 * hiq_); load_frag4(kn0, kpq_); }
#define NA_DESC(uu_, h_, jb_, sb_, rows_, klo_, khi_) const int h_ = (uu_) / NTILE; int jb_, sb_, rows_, klo_, khi_; { const int pm_ = (uu_) - h_ * NTILE; int seq_, T_; tile_seq(pm_, seq_, jb_, T_, sb_); rows_ = T_ / 64; \
                        klo_ = 4 * jb_ - 4; klo_ = klo_ < 0 ? 0 : klo_; klo_ = klo_ > rows_ - 8 ? rows_ - 8 : klo_; khi_ = 4 * jb_ + 3 - 4; khi_ = khi_ < 0 ? 0 : khi_; khi_ = khi_ > rows_ - 8 ? rows_ - 8 : khi_; khi_ += 8; }
                    if (vcu < N) { NA_DESC(vcu, h0, jb0, sb0, rows0, klo0, khi0);
                        vt_load<6>(VR, PROJ + 1536 + h0 * 64, 2560, sb0 + klo0 * 64, 0, (khi0 - klo0) * 64); { const int tr = tid >> 5, tc = tid & 31; rpbv = (tr < 15 && tc < 31) ? rpb_b[h0 * 465 + tr * 31 + tc] * LOG2E : -INFINITY; } NA_QK(vcu); }
                    for (int u = vcu; u < N; u += G) {
                        NA_DESC(u, h, jb, seqbase, rows, klo, khi);
                        const int rp = wave >> 2, a = wave & 3, q = lane & 31, hi = lane >> 5;
                        const int rA = 4 * jb + 2 * rp, row_q = rA + (q >> 4), c = 16 * a + (q & 15);
                        int col0 = 16 * a - 8; col0 = col0 < 0 ? 0 : col0; col0 = col0 > 32 ? 32 : col0;
                        int r0q = row_q - 4; r0q = r0q < 0 ? 0 : r0q; r0q = r0q > rows - 8 ? rows - 8 : r0q;
                        int kr_lo = rA - 4; kr_lo = kr_lo < 0 ? 0 : kr_lo; kr_lo = kr_lo > rows - 8 ? rows - 8 : kr_lo;
                        int kr_hi = rA + 1 - 4; kr_hi = kr_hi < 0 ? 0 : kr_hi; kr_hi = kr_hi > rows - 8 ? rows - 8 : kr_hi; kr_hi += 7;
                        const bf16* kptr = PROJ + 768 + h * 64 + 8 * hi + (size_t)(seqbase + kr_lo * 64 + col0 + q) * 2560;
                        bf16x8 qf[4], kf[4], kf1[4];
#pragma unroll
                        for (int ks = 0; ks < 4; ++ks) { qf[ks] = qn[ks]; kf[ks] = kn0[ks]; }
                        load_frag4(kf1, kptr + (size_t)64 * 2560);
                        LDS_BARRIER();
                        vt_store<6>(VR, lds, 708, 0, (khi - klo) * 64);
                        rpbL[tid] = rpbv;
                        LDS_BARRIER();
                        const int un = u + G;
                        if (un < N) { NA_DESC(un, h2, jb2, sb2, rows2, klo2, khi2);
                            vt_load<6>(VR, PROJ + 1536 + h2 * 64, 2560, sb2 + klo2 * 64, 0, (khi2 - klo2) * 64); { const int tr = tid >> 5, tc = tid & 31; rpbv = (tr < 15 && tc < 31) ? rpb_b[h2 * 465 + tr * 31 + tc] * LOG2E : -INFINITY; } NA_QK(un); }
                        na_chunk(lds, 708 * 2, rpbL, kptr, OB + (size_t)(seqbase + row_q * 64 + c) * 1024 + h * 64, qf, kf, kf1, row_q, c, col0, r0q, kr_lo, kr_hi, klo, lane);
                    }
#undef NA_QK
#undef NA_DESC
                }
                mem_units(lds, PROJ, 2560, 2304, MKV, 1, OB, wave, lane, vcu);
            }
        }
        SEAM(pb + 1);
        if (IN(pb + 2)) {
            LOAD_ARGS();
            pg8::Gemm g{OB, Wo + (size_t)layer * 1024 * 1024, MTOK, D, D, 0}; pg8::StaticOrder S; S.init(MTOK, D, G, bx);
            pg8::EpiResid E{XB, SS, ldsx};
            pg8::gemm_phase<pg8::EpiResid, pg8::StaticOrder>(lds, g, S, E);
        }
        SEAM(pb + 2);
        if (IN(pb + 3)) {
            LOAD_ARGS();
            const float* conv_w = ARG(15); const float* conv_b = ARG(16);
            pg8::Gemm g{XB, Wgu + (size_t)layer * 5632 * 1024, MTOK, 5632, D, 0}; pg8::StaticOrder S; S.init(MTOK, 5632, G, bx);
            pg8::EpiGateUp E{ACT, SS, conv_w + (size_t)layer * 3 * FF, conv_b + (size_t)layer * FF, SB, ldsx};
            if (tid < 128) { ldsx[tid] = 0.f; ldsx[(17 + 16) * 128 + tid] = 0.f; }
            __syncthreads();
            for (int rep = 0; rep < NREP(6); ++rep) pg8::gemm_phase<pg8::EpiGateUp, pg8::StaticOrder>(lds, g, S, E);
        }
        SEAM(pb + 3);
        if (IN(pb + 4)) {
            LOAD_ARGS();
            const float* conv_w = ARG(15);
            const float* cw = conv_w + (size_t)layer * 3 * FF;
            for (int idx = bx * (NWAVES * 64) + tid; idx < NTILE * 2 * FF; idx += G * NWAVES * 64) {
                const int col = idx % FF, pw = idx / FF, pm = pw >> 1, which = pw & 1;
                const float part = SB[(size_t)(pw * 3 + 1) * FF + col], uu = SB[(size_t)(pw * 3 + 2) * FF + col];
                const bool seq_start = (pm < 256) ? ((pm & 7) == 0) : (pm == 256);
                const bool seq_end = (pm < 256) ? ((pm & 7) == 7) : (pm == NTILE - 1);
                float c = part;
                if (which == 0) { if (!seq_start) c += cw[col] * SB[(size_t)(((pm - 1) * 2 + 1) * 3) * FF + col]; }
                else { if (!seq_end) c += cw[2 * FF + col] * SB[(size_t)(((pm + 1) * 2) * 3) * FF + col]; }
                const float sg = 1.0f / (1.0f + __builtin_amdgcn_exp2f(-LOG2E * c));
                ACT[pg8::ilv_off(pm * 256 + (which ? 255 : 0), col, FF)] = (bf16)f2bf(c * sg * uu);
            }
        }
        SEAM(pb + 4);
        if (IN(pb + 5)) {
            LOAD_ARGS();
            pg8::Gemm g{ACT, Wd + (size_t)layer * 1024 * FF, MTOK, D, FF, 1}; pg8::StaticOrder S; S.init(MTOK, D, G, bx);
            if constexpr (layer == 0) {
                pg8::EpiResid E{XB, SS, ldsx};
                pg8::gemm_phase<pg8::EpiResid, pg8::StaticOrder>(lds, g, S, E);
            } else {
                pg8::EpiFinal E{XB, out, ARG(18), (float*)(ws + WS_XS), (unsigned*)(ws + WS_CTL) + CW_PANEL, ldsx};
                pg8::gemm_phase<pg8::EpiFinal, pg8::StaticOrder>(lds, g, S, E);
            }
        }
        if constexpr (layer == 0) { SEAM(pb + 5); }
#undef IN
#undef SEAM
}

__global__ void __launch_bounds__(NWAVES * 64, 2) mega_fwd(Args args) {
    extern __shared__ __attribute__((aligned(16))) unsigned char lds_raw[];
    LAS unsigned char* lds = (LAS unsigned char*)lds_raw;
    const int G = gridDim.x, bx = blockIdx.x;
    if (threadIdx.x < 16) ((volatile LAS unsigned*)(lds + MISC_OFF))[threadIdx.x] = 0u;
    __syncthreads();
    { const CAS Args* apc_ = (const CAS Args*)__builtin_amdgcn_kernarg_segment_ptr(); if (apc_->ph_hi - apc_->ph_lo > 1 && threadIdx.x == 0) (void)xb_add((unsigned*)(apc_->ws + WS_CTL) + XB_XCNT(xb_xcc_id()), 1u); }
#define PHASE_TID() int tid = threadIdx.x; asm volatile("" : "+v"(tid)); const int lane = tid & 63, wave = __builtin_amdgcn_readfirstlane(tid >> 6); (void)lane; (void)wave;
    LAS float* ldsx = (LAS float*)(lds + LDS_X_OFF);

    int lo, hi_ph; { const CAS Args* ap0 = (const CAS Args*)__builtin_amdgcn_kernarg_segment_ptr(); lo = ap0->ph_lo; hi_ph = ap0->ph_hi; }
#define IN(k) (lo <= (k) && (k) < hi_ph)
#define SEAM(k) do { if (IN(k) && IN((k) + 1)) { if ((k) == 0) cg::this_grid().sync(); else { const CAS Args* apb_ = (const CAS Args*)__builtin_amdgcn_kernarg_segment_ptr(); asm volatile("" : "+s"(apb_)); xcd_barrier((unsigned*)(apb_->ws + WS_CTL), (volatile LAS unsigned*)(lds + MISC_OFF)); } } } while (0)

    if (IN(0)) {
        LOAD_ARGS(); PHASE_TID();
        const float* x_prompt = ARG(0); const float* x_sample = ARG(1); const float* mem_prompt = ARG(2); const float* mem_sample = ARG(3); const float* g_mix = ARG(4); const float* g_mem = ARG(5);
        const float* w_in_a = ARG(6); const float* w_in_b = ARG(8); const float* w_mem_kv = ARG(10); const float* w_o = ARG(11); const float* g_ffn = ARG(12); const float* w_gate = ARG(13); const float* w_up = ARG(14); const float* w_down = ARG(17);
        LAS float* scr = (LAS float*)(lds + wave * 16384);
        const int gw = bx * NWAVES + wave, NGW = G * NWAVES;
        constexpr int I_INA = 16 * 48, I_INB = 16 * 80, I_MKV = 16 * 16, I_O = 16 * 32, I_G = 16 * 88, I_D = 44 * 32;
        constexpr int NITEMS = I_INA + I_INB + 2 * I_MKV + 2 * I_O + 4 * I_G + 2 * I_D;
        for (int rep = 0; rep < NREP(0); ++rep) {
        for (int it = gw; it < NITEMS; it += NGW) {
            int r = it;
            if (r < I_INA) { p0_transpose_item(w_in_a, 1024, 1536, WinA, 0, 0, g_mix, scr, r, lane); continue; } r -= I_INA;
            if (r < I_INB) { p0_transpose_item(w_in_b, 1024, 2560, WinB, 0, 0, g_mix + 1024, scr, r, lane); continue; } r -= I_INB;
            if (r < 2 * I_MKV) { const int li = r / I_MKV; p0_transpose_item(w_mem_kv + (size_t)li * 1024 * 512, 1024, 512, Wmkv, li * 512, 0, g_mem + li * 1024, scr, r % I_MKV, lane); continue; } r -= 2 * I_MKV;
            if (r < 2 * I_O) { const int li = r / I_O; p0_transpose_item(w_o + (size_t)li * 1024 * 1024, 1024, 1024, Wo + (size_t)li * 1024 * 1024, 0, 0, nullptr, scr, r % I_O, lane); continue; } r -= 2 * I_O;
            if (r < 4 * I_G) { const int li = r / (2 * I_G), rr = r % (2 * I_G), isup = rr / I_G;
                p0_transpose_item((isup ? w_up : w_gate) + (size_t)li * 1024 * FF, 1024, FF, Wgu + (size_t)li * 5632 * 1024, 0, 1 + isup, g_ffn + li * 1024, scr, rr % I_G, lane); continue; } r -= 4 * I_G;
            { const int li = r / I_D; p0_transpose_item(w_down + (size_t)li * FF * 1024, FF, 1024, Wd + (size_t)li * 1024 * FF, 0, 0, nullptr, scr, r % I_D, lane); }
        }
        for (int m = gw; m < MTOK + MMEM; m += NGW) {
            if (m < MTOK) { const float* xr = m < MPROMPT ? x_prompt + (size_t)m * D : x_sample + (size_t)(m - MPROMPT) * D; row_to_bf16(xr, XB + (size_t)m * D, SS + (size_t)m * 4, lane); }
            else { const int mm = m - MTOK; const float* xr = mm < 8192 ? mem_prompt + (size_t)mm * D : mem_sample + (size_t)(mm - 8192) * D; row_to_bf16(xr, MB + (size_t)mm * D, SSM + (size_t)mm * 4, lane); }
        }
        }
    }
    SEAM(0);

    layer_phases<0>(lds, ldsx, lo, hi_ph, G, bx);
    layer_phases<1>(lds, ldsx, lo, hi_ph, G, bx);
#undef IN
#undef SEAM
}

constexpr int N_PHASES = 13;
extern "C" void kernel_launch(void* const* d_in, const int* in_sizes, int n_in, void* d_out, int out_size, void* d_ws, size_t ws_size, hipStream_t stream) {
    static int grid = 0;
    if (grid == 0) {
        if (n_in != 19 || out_size != MTOK * D || ws_size < WS_END) { fprintf(stderr, "kernel_launch: unexpected shapes n_in %d out %d ws %zu\n", n_in, out_size, ws_size); grid = -1; return; }
        int dev = 0, cus = 0, per_cu = 0;
        if (hipGetDevice(&dev) != hipSuccess || hipDeviceGetAttribute(&cus, hipDeviceAttributeMultiprocessorCount, dev) != hipSuccess) { grid = -1; return; }
        if (hipFuncSetAttribute((const void*)mega_fwd, hipFuncAttributeMaxDynamicSharedMemorySize, LDS_BYTES) != hipSuccess) { fprintf(stderr, "kernel_launch: hipFuncSetAttribute failed\n"); grid = -1; return; }
        if (hipOccupancyMaxActiveBlocksPerMultiprocessor(&per_cu, (const void*)mega_fwd, NWAVES * 64, LDS_BYTES) != hipSuccess || per_cu < 1) { fprintf(stderr, "kernel_launch: occupancy query says %d\n", per_cu); per_cu = 1; }
        (void)hipGetLastError();
        grid = cus * 1;
    }
    if (grid < 0) return;
    if (hipMemsetAsync((char*)d_ws + WS_CTL, 0, CTL_ZERO_BYTES, stream) != hipSuccess) { fprintf(stderr, "kernel_launch: memset failed\n"); return; }
    Args a{};
    for (int i = 0; i < 19; ++i) a.in[i] = (const float*)d_in[i];
    a.out = (float*)d_out; a.ws = (unsigned char*)d_ws;
#if MK_ONE_LAUNCH
    a.ph_lo = 0; a.ph_hi = N_PHASES;
    void* kargs[] = {&a};
    hipError_t e = hipLaunchCooperativeKernel((const void*)mega_fwd, dim3(grid), dim3(NWAVES * 64), kargs, LDS_BYTES, stream);
    if (e != hipSuccess) fprintf(stderr, "cooperative launch failed: %s (grid %d)\n", hipGetErrorString(e), grid);
#else
    for (int p = 0; p < N_PHASES; ++p) { a.ph_lo = p; a.ph_hi = p + 1; hipLaunchKernelGGL(mega_fwd, dim3(grid), dim3(NWAVES * 64), LDS_BYTES, stream, a); }
#endif
}
```

```cpp
#include <hip/hip_runtime.h>
#include <hip/hip_cooperative_groups.h>
#include <cstdio>
#include <cstdint>
namespace cg = cooperative_groups;

#ifndef PROBE_REP
#define PROBE_REP 0
#endif
#define NREP(k) (((PROBE_REP >> (k)) & 1) ? 2 : 1)
#ifndef MK_ONE_LAUNCH
#define MK_ONE_LAUNCH 1
#endif

namespace pg8 {
#define PG8_LAS __attribute__((address_space(3)))
typedef unsigned short bf16_t;
typedef short bf16x8 __attribute__((ext_vector_type(8)));
typedef float f32x4 __attribute__((ext_vector_type(4)));
typedef unsigned u32x4 __attribute__((ext_vector_type(4)));
typedef unsigned u32x2 __attribute__((ext_vector_type(2)));
constexpr int BM = 256, BK = 64, HALF = 128, HTB = HALF * BK * 2, STAGE_BYTES = 8 * HTB, NXCD = 8, WGM = 8;

__host__ __device__ __forceinline__ int lds_byte(int r, int c) { const int st = (r >> 4) * 2 + (c >> 5), rr = r & 15, cc = c & 31, ob = rr * 64 + cc * 2; return st * 1024 + (ob ^ (((ob >> 9) & 1) << 5)); }
__host__ __device__ __forceinline__ void stage_rc(int b, int& R, int& C) { const int st = b / 1024, sb = b % 1024, swz = sb ^ (((sb >> 9) & 1) << 5); R = (st >> 1) * 16 + swz / 64; C = (st & 1) * 32 + (swz % 64) / 2; }
__host__ __device__ __forceinline__ int perm32(int rho) { const int n = rho >> 4, i = rho & 15; return 8 * (i >> 2) + 4 * n + (i & 3); }

__host__ __device__ __forceinline__ size_t ilv_off(int r, int k, int K) { return (size_t)(r >> 4) * (16 * (size_t)K) + (size_t)(r & 7) * (2 * (size_t)K) + (size_t)(k >> 5) * 64 + (size_t)((r >> 3) & 1) * 32 + (k & 31); }
struct Unit { int pm, pn; };
struct Gemm { const bf16_t* A; const bf16_t* Bt; int M, N, K, ailv; };

struct StaticOrder {
    int nM, nN, nwg, G, c;
    __host__ __device__ void init(int M, int N, int G_, int c_) { nM = M / BM; nN = N / BM; nwg = nM * nN; G = G_; c = c_; }
    __host__ __device__ bool next(int i, Unit& u) const {
        const long L = (long)i * G + c; if (L >= nwg) return false;
        int wgid = (int)L; { const int q = nwg / NXCD, r = nwg % NXCD, xcd = wgid % NXCD, off = wgid / NXCD; wgid = (xcd < r ? xcd * (q + 1) : r * (q + 1) + (xcd - r) * q) + off; }
        const int nig = WGM * nN, gid = wgid / nig, fm = gid * WGM, gsz = (nM - fm) < WGM ? (nM - fm) : WGM;
        u.pm = fm + ((wgid % nig) % gsz); u.pn = (wgid % nig) / gsz; return true;
    }
};

__device__ __forceinline__ unsigned cvt_pk_bf16(float lo, float hi) { unsigned r; asm volatile("v_cvt_pk_bf16_f32 %0, %1, %2" : "=v"(r) : "v"(lo), "v"(hi)); return r; }
__device__ __forceinline__ float rstd_of(const float* ss, int row) { const f32x4 p = *(const f32x4*)(ss + (size_t)row * 4); return __builtin_amdgcn_rsqf(((p[0] + p[1]) + (p[2] + p[3])) * (1.0f / 1024.0f) + 1e-6f); }


__device__ __forceinline__ u32x4 xchg8(const u32x4 v) {
    u32x4 r;
#pragma unroll
    for (int i = 0; i < 4; ++i) r[i] = (unsigned)__builtin_amdgcn_update_dpp(0, (int)v[i], 0x128, 0xf, 0xf, true);
    return r;
}
__device__ __forceinline__ u32x4 sel4(bool c, const u32x4 a, const u32x4 b) { u32x4 r; r.x = c ? a.x : b.x; r.y = c ? a.y : b.y; r.z = c ? a.z : b.z; r.w = c ? a.w : b.w; return r; }

struct EpiScaleBf16 {
    static constexpr bool PERM = true;
    bf16_t* O; int ldc; const float* ss;
    __device__ __forceinline__ void operator()(f32x4 (&acc)[2][2][4][2], const Unit& u, int wr, int wc, int fr, int fq) const {
        asm volatile("" : "+v"(fr), "+v"(fq)); asm volatile("" : "+s"(wr), "+s"(wc));
        const bool lo = fr < 8;
        const int row0 = u.pm * BM + wr * 64 + fr, col0 = u.pn * BM + wc * 64 + 8 * fq;
        bf16_t* base = O + (size_t)(u.pm * BM + wr * 64 + (fr & 7)) * ldc + col0 + (lo ? 0 : 32);
#pragma unroll
        for (int ai = 0; ai < 2; ++ai)
#pragma unroll
            for (int m = 0; m < 4; ++m) {
                const float rs = rstd_of(ss, row0 + ai * HALF + m * 16);
                u32x4 w[2];
#pragma unroll
                for (int bj = 0; bj < 2; ++bj) { const f32x4 v0 = acc[ai][bj][m][0] * rs, v1 = acc[ai][bj][m][1] * rs;
                    w[bj].x = cvt_pk_bf16(v0[0], v0[1]); w[bj].y = cvt_pk_bf16(v0[2], v0[3]); w[bj].z = cvt_pk_bf16(v1[0], v1[1]); w[bj].w = cvt_pk_bf16(v1[2], v1[3]); }
                const u32x4 y = xchg8(sel4(lo, w[1], w[0]));
                bf16_t* rp = base + (size_t)(ai * HALF + m * 16) * ldc;
                *(u32x4*)rp = sel4(lo, w[0], y);
                *(u32x4*)(rp + (size_t)8 * ldc) = sel4(lo, y, w[1]);
            }
    }
};

__device__ __forceinline__ f32x4 bf_lo4(unsigned w0, unsigned w1) { return (f32x4){__builtin_bit_cast(float, w0 << 16), __builtin_bit_cast(float, w0 & 0xffff0000u), __builtin_bit_cast(float, w1 << 16), __builtin_bit_cast(float, w1 & 0xffff0000u)}; }
struct EpiResid {
    static constexpr bool PERM = true;
    bf16_t* xb; float* ss; PG8_LAS float* red;
    __device__ __forceinline__ void operator()(f32x4 (&acc)[2][2][4][2], const Unit& u, int wr, int wc, int fr, int fq) const {
        asm volatile("" : "+v"(fr), "+v"(fq)); asm volatile("" : "+s"(wr), "+s"(wc));
        const bool lo = fr < 8;
        const int col0 = u.pn * BM + wc * 64 + 8 * fq;
        bf16_t* base = xb + (size_t)(u.pm * BM + wr * 64 + (fr & 7)) * 1024 + col0 + (lo ? 0 : 32);
#pragma unroll
        for (int ai = 0; ai < 2; ++ai)
#pragma unroll
            for (int m = 0; m < 4; ++m) {
                const int rl = ai * HALF + wr * 64 + m * 16 + fr;
                bf16_t* rp = base + (size_t)(ai * HALF + m * 16) * 1024;
                const u32x4 la = *(const u32x4*)rp, lb = *(const u32x4*)(rp + (size_t)8 * 1024);
                const u32x4 yi = xchg8(sel4(lo, lb, la));
                u32x4 xo[2]; xo[0] = sel4(lo, la, yi); xo[1] = sel4(lo, yi, lb);
                float sq = 0.f; u32x4 w[2];
#pragma unroll
                for (int bj = 0; bj < 2; ++bj) {
                    const f32x4 v0 = acc[ai][bj][m][0] + bf_lo4(xo[bj].x, xo[bj].y), v1 = acc[ai][bj][m][1] + bf_lo4(xo[bj].z, xo[bj].w);
                    sq += (v0[0] * v0[0] + v0[1] * v0[1]) + (v0[2] * v0[2] + v0[3] * v0[3]) + (v1[0] * v1[0] + v1[1] * v1[1]) + (v1[2] * v1[2] + v1[3] * v1[3]);
                    w[bj].x = cvt_pk_bf16(v0[0], v0[1]); w[bj].y = cvt_pk_bf16(v0[2], v0[3]); w[bj].z = cvt_pk_bf16(v1[0], v1[1]); w[bj].w = cvt_pk_bf16(v1[2], v1[3]);
                }
                const u32x4 yo = xchg8(sel4(lo, w[1], w[0]));
                *(u32x4*)rp = sel4(lo, w[0], yo); *(u32x4*)(rp + (size_t)8 * 1024) = sel4(lo, yo, w[1]);
                sq += __shfl_xor(sq, 16); sq += __shfl_xor(sq, 32);
                if (fq == 0) red[rl * 4 + wc] = sq;
            }
        asm volatile("s_waitcnt lgkmcnt(0)" ::: "memory"); __builtin_amdgcn_s_barrier(); asm volatile("" ::: "memory");
        const int tid = threadIdx.x;
        if (tid < 256) { const f32x4 p = *(const PG8_LAS f32x4*)(red + tid * 4); ss[(size_t)(u.pm * BM + tid) * 4 + u.pn] = (p[0] + p[1]) + (p[2] + p[3]); }
    }
};

struct EpiFinal {
    static constexpr bool PERM = true;
    const bf16_t* xb; float* xout; const float* gfin; float* xs; unsigned* cnt; PG8_LAS float* red;
    __device__ __forceinline__ void operator()(f32x4 (&acc)[2][2][4][2], const Unit& u, int wr, int wc, int fr, int fq) const {
        asm volatile("" : "+v"(fr), "+v"(fq)); asm volatile("" : "+s"(wr), "+s"(wc));
        const bool lo = fr < 8;
        const int col0 = u.pn * BM + wc * 64 + 8 * fq;
#pragma unroll
        for (int ai = 0; ai < 2; ++ai)
#pragma unroll
            for (int m = 0; m < 4; ++m) {
                const int rl = ai * HALF + wr * 64 + m * 16 + fr;
                const bf16_t* rp = xb + (size_t)(u.pm * BM + wr * 64 + (fr & 7) + ai * HALF + m * 16) * 1024 + col0 + (lo ? 0 : 32);
                const u32x4 la = *(const u32x4*)rp, lb = *(const u32x4*)(rp + (size_t)8 * 1024);
                const u32x4 yi = xchg8(sel4(lo, lb, la));
                u32x4 xo2[2]; xo2[0] = sel4(lo, la, yi); xo2[1] = sel4(lo, yi, lb);
                float sq = 0.f;
#pragma unroll
                for (int bj = 0; bj < 2; ++bj) {
                    const u32x4 xo = xo2[bj];
                    const f32x4 v0 = acc[ai][bj][m][0] + bf_lo4(xo.x, xo.y), v1 = acc[ai][bj][m][1] + bf_lo4(xo.z, xo.w);
                    sq += (v0[0] * v0[0] + v0[1] * v0[1]) + (v0[2] * v0[2] + v0[3] * v0[3]) + (v1[0] * v1[0] + v1[1] * v1[1]) + (v1[2] * v1[2] + v1[3] * v1[3]);
                    acc[ai][bj][m][0] = v0; acc[ai][bj][m][1] = v1;
                }
                sq += __shfl_xor(sq, 16); sq += __shfl_xor(sq, 32);
                if (fq == 0) red[rl * 4 + wc] = sq;
            }
        asm volatile("s_waitcnt lgkmcnt(0)" ::: "memory"); __builtin_amdgcn_s_barrier(); asm volatile("" ::: "memory");
        const int tid = threadIdx.x;
        unsigned* cw_ = cnt + 64 * u.pm;
        if (tid < 256) {
            const f32x4 p = *(const PG8_LAS f32x4*)(red + tid * 4);
            __hip_atomic_store(xs + (size_t)(u.pm * 4 + u.pn) * 256 + tid, (p[0] + p[1]) + (p[2] + p[3]), __ATOMIC_RELAXED, __HIP_MEMORY_SCOPE_AGENT);
            asm volatile("s_waitcnt vmcnt(0)" ::: "memory");
            if ((tid & 63) == 0) __hip_atomic_fetch_add(cw_, 1u, __ATOMIC_RELAXED, __HIP_MEMORY_SCOPE_AGENT);
        }
        if (tid < 64) {
            unsigned sp = 0u;
            while ((unsigned)__builtin_amdgcn_readfirstlane(__hip_atomic_load(cw_, __ATOMIC_RELAXED, __HIP_MEMORY_SCOPE_AGENT)) < 16u) { __builtin_amdgcn_s_sleep(2); if (++sp > (1u << 24)) break; }
            __builtin_amdgcn_fence(__ATOMIC_ACQUIRE, "agent");
        }
        asm volatile("s_waitcnt vmcnt(0) lgkmcnt(0)" ::: "memory"); __builtin_amdgcn_s_barrier(); asm volatile("" ::: "memory");
        if (tid < 256) {
            const float* xp = xs + (size_t)(u.pm * 4) * 256 + tid;
            const float t0 = __hip_atomic_load(xp, __ATOMIC_RELAXED, __HIP_MEMORY_SCOPE_AGENT), t1 = __hip_atomic_load(xp + 256, __ATOMIC_RELAXED, __HIP_MEMORY_SCOPE_AGENT),
                        t2 = __hip_atomic_load(xp + 512, __ATOMIC_RELAXED, __HIP_MEMORY_SCOPE_AGENT), t3 = __hip_atomic_load(xp + 768, __ATOMIC_RELAXED, __HIP_MEMORY_SCOPE_AGENT);
            red[1024 + tid] = __builtin_amdgcn_rsqf(((t0 + t1) + (t2 + t3)) * (1.0f / 1024.0f) + 1e-6f);
        }
        asm volatile("s_waitcnt lgkmcnt(0)" ::: "memory"); __builtin_amdgcn_s_barrier(); asm volatile("" ::: "memory");
        f32x4 gv[2][2];
#pragma unroll
        for (int bj = 0; bj < 2; ++bj) { gv[bj][0] = *(const f32x4*)(gfin + col0 + bj * 32); gv[bj][1] = *(const f32x4*)(gfin + col0 + bj * 32 + 4); }
#pragma unroll
        for (int ai = 0; ai < 2; ++ai)
#pragma unroll
            for (int m = 0; m < 4; ++m) {
                const int rl = ai * HALF + wr * 64 + m * 16 + fr;
                const float rs = red[1024 + rl];
                float* xo = xout + (size_t)(u.pm * BM + wr * 64 + (fr & 7) + ai * HALF + m * 16) * 1024 + col0 + (lo ? 0 : 4);
#pragma unroll
                for (int bj = 0; bj < 2; ++bj) {
                    const f32x4 w0 = acc[ai][bj][m][0] * rs * gv[bj][0], w1 = acc[ai][bj][m][1] * rs * gv[bj][1];
                    const u32x4 u0 = __builtin_bit_cast(u32x4, w0), u1 = __builtin_bit_cast(u32x4, w1);
                    const u32x4 y = xchg8(sel4(lo, u1, u0));
                    *(u32x4*)(xo + bj * 32) = sel4(lo, u0, y);
                    *(u32x4*)(xo + (size_t)8 * 1024 + bj * 32) = sel4(lo, y, u1);
                }
            }
    }
};

struct EpiGateUp {
    static constexpr bool PERM = true;
    bf16_t* act; const float* ss; const float* cw; const float* cb; float* sb; PG8_LAS float* edge;
    __device__ __forceinline__ void operator()(f32x4 (&acc)[2][2][4][2], const Unit& u, int wr, int wc, int fr, int fq) const {
        asm volatile("" : "+v"(fr), "+v"(fq)); asm volatile("" : "+s"(wr), "+s"(wc));
        const int slot0 = wc * 32 + 8 * fq, fcol0 = u.pn * 128 + slot0;
#pragma unroll
        for (int ai = 0; ai < 2; ++ai)
#pragma unroll
            for (int m = 0; m < 4; ++m) {
                const float rs = rstd_of(ss, u.pm * BM + ai * HALF + wr * 64 + m * 16 + fr);
#pragma unroll
                for (int bj = 0; bj < 2; ++bj)
#pragma unroll
                    for (int n = 0; n < 2; ++n) acc[ai][bj][m][n] = acc[ai][bj][m][n] * rs;
            }
        PG8_LAS float* eB = edge + slot0, * eT = edge + 17 * 128 + slot0;
        if (fr == 0 || fr == 15) {
            PG8_LAS float* e0 = (fr == 15 ? eB + 128 : eT) + wr * 4 * 128;
#pragma unroll
            for (int ai = 0; ai < 2; ++ai)
#pragma unroll
                for (int m = 0; m < 4; ++m) { *(PG8_LAS f32x4*)(e0 + (ai * 8 + m) * 128) = acc[ai][0][m][0]; *(PG8_LAS f32x4*)(e0 + (ai * 8 + m) * 128 + 4) = acc[ai][0][m][1]; }
        }
        asm volatile("s_waitcnt lgkmcnt(0)" ::: "memory"); __builtin_amdgcn_s_barrier(); asm volatile("" ::: "memory");
        const PG8_LAS float* rB = eB + wr * 4 * 128, * rT = eT + (wr * 4 + 1) * 128;
        const int rowb = u.pm * BM + wr * 64 + fr;
        u32x2 keep[2][4];
#pragma unroll
        for (int n = 0; n < 2; ++n) {
            const f32x4 w0 = *(const f32x4*)(cw + fcol0 + 4 * n), w1 = *(const f32x4*)(cw + 2816 + fcol0 + 4 * n), w2 = *(const f32x4*)(cw + 5632 + fcol0 + 4 * n), bb = *(const f32x4*)(cb + fcol0 + 4 * n);
#pragma unroll
            for (int ai = 0; ai < 2; ++ai)
#pragma unroll
                for (int m = 0; m < 4; ++m) {
                    const f32x4 ep = *(const PG8_LAS f32x4*)(rB + (ai * 8 + m) * 128 + 4 * n), en = *(const PG8_LAS f32x4*)(rT + (ai * 8 + m) * 128 + 4 * n);
                    f32x4 cv, av;
#pragma unroll
                    for (int e = 0; e < 4; ++e) {
                        const float g = acc[ai][0][m][n][e];
                        const float up = __builtin_bit_cast(float, __builtin_amdgcn_update_dpp(0, __builtin_bit_cast(int, g), 0x111, 0xf, 0xf, true));
                        const float dn = __builtin_bit_cast(float, __builtin_amdgcn_update_dpp(0, __builtin_bit_cast(int, g), 0x101, 0xf, 0xf, true));
                        const float prev = (fr == 0) ? ep[e] : up, next = (fr == 15) ? en[e] : dn;
                        const float c = w0[e] * prev + w1[e] * g + w2[e] * next + bb[e];
                        const float sg = __builtin_amdgcn_rcpf(1.0f + __builtin_amdgcn_exp2f(-1.4426950408889634f * c));
                        cv[e] = c; av[e] = c * sg * acc[ai][1][m][n][e];
                    }
                    const bool seam = (ai == 0 && m == 0) ? (wr == 0 && fr == 0) : ((ai == 1 && m == 3) ? (wr == 1 && fr == 15) : false);
                    if (seam) {
                        float* s = sb + (size_t)((u.pm * 2 + ai) * 3) * 2816 + fcol0 + 4 * n;
                        *(f32x4*)(s) = acc[ai][0][m][n]; *(f32x4*)(s + 2816) = cv; *(f32x4*)(s + 5632) = acc[ai][1][m][n];
                    }
                    {
                        u32x2 w; w.x = cvt_pk_bf16(av[0], av[1]); w.y = cvt_pk_bf16(av[2], av[3]);
                        if (n == 0) keep[ai][m] = w;
                        else if (!seam) { u32x4 w4; w4.x = keep[ai][m].x; w4.y = keep[ai][m].y; w4.z = w.x; w4.w = w.y; *(u32x4*)(act + ilv_off(rowb + ai * HALF + m * 16, fcol0, 2816)) = w4; }
                    }
                }
        }
    }
};

template <class Epi, class Sched, bool ALIGN_EPI = true, bool SP2 = true>
__device__ __forceinline__ void gemm_phase(PG8_LAS unsigned char* lds, const Gemm g, const Sched& S, const Epi& E) {
    int tid = threadIdx.x; asm volatile("" : "+v"(tid));
    const int wid = __builtin_amdgcn_readfirstlane(tid >> 6), lane = tid & 63, wr = wid >> 2, wc = wid & 3, fr = lane & 15, fq = lane >> 4;
    const int K = g.K, nt = K / BK;
    unsigned voffA[2], voffB[2];
#pragma unroll
    for (int i = 0; i < 2; ++i) { int R, C; stage_rc(tid * 16 + i * 8192, R, C); const int Rb = Epi::PERM ? (64 * (R >> 5) + perm32(R & 31)) : R;
        voffA[i] = g.ailv ? (unsigned)ilv_off(R, C, K) * 2u : (unsigned)(R * K + C) * 2u; voffB[i] = (unsigned)(Rb * K + C) * 2u; }
    const size_t kstep = (size_t)(BK * 2), kstepA = g.ailv ? 2 * kstep : kstep;
    const size_t hstepA = (size_t)HALF * K * 2, hstepB = (size_t)32 * K * 2;
    const size_t tstep = 2 * hstepA;
    const unsigned ldsw = (unsigned)wid * 1024u;
    const int aoff = lds_byte(wr * 64 + fr, fq * 8), boff = lds_byte(wc * 32 + fr, fq * 8);
#define PG8_SA(b, h) (((b) * 2 + (h)) * HTB)
#define PG8_SB(b, h) ((4 + (b) * 2 + (h)) * HTB)
#define PG8_STAGE(bufoff, gbase, voff) do { _Pragma("unroll") for (int _i = 0; _i < 2; ++_i) \
        __builtin_amdgcn_global_load_lds((const unsigned*)((const char*)(gbase) + (voff)[_i]), (PG8_LAS unsigned*)(lds + (bufoff) + ldsw + _i * 8192), 16, 0, 0); } while (0)
#define PG8_LDA(dst, b, h) do { _Pragma("unroll") for (int m = 0; m < 4; ++m) _Pragma("unroll") for (int k = 0; k < 2; ++k) dst[m][k] = *(const PG8_LAS bf16x8*)(lds + PG8_SA(b, h) + aoff + m * 2048 + k * 1024); } while (0)
#define PG8_LDB(dst, b, h) do { _Pragma("unroll") for (int n = 0; n < 2; ++n) _Pragma("unroll") for (int k = 0; k < 2; ++k) dst[n][k] = *(const PG8_LAS bf16x8*)(lds + PG8_SB(b, h) + boff + n * 2048 + k * 1024); } while (0)
#define PG8_MMA(ai, bj, At, Bt) do { __builtin_amdgcn_s_setprio(1); _Pragma("unroll") for (int m = 0; m < 4; ++m) _Pragma("unroll") for (int n = 0; n < 2; ++n) _Pragma("unroll") for (int k = 0; k < 2; ++k) \
        acc[ai][bj][m][n] = __builtin_amdgcn_mfma_f32_16x16x32_bf16(Bt[n][k], At[m][k], acc[ai][bj][m][n], 0, 0, 0); __builtin_amdgcn_s_setprio(0); } while (0)
#define PG8_WAIT_V(n) asm volatile("s_waitcnt vmcnt(" #n ")" ::: "memory")
#define PG8_WAIT_L(n) asm volatile("s_waitcnt lgkmcnt(" #n ")" ::: "memory")
#define PG8_BAR __builtin_amdgcn_s_barrier()
#define PG8_SCHED __builtin_amdgcn_sched_barrier(0)
    Unit cur, nxt; int ui = 0;
    if (!S.next(0, cur)) return;
    f32x4 acc[2][2][4][2];
#pragma unroll
    for (int a = 0; a < 2; ++a)
#pragma unroll
        for (int b = 0; b < 2; ++b)
#pragma unroll
            for (int m = 0; m < 4; ++m)
#pragma unroll
                for (int n = 0; n < 2; ++n) acc[a][b][m][n] = (f32x4){0.f, 0.f, 0.f, 0.f};
    bf16x8 At[4][2], B0[2][2], B1[2][2];
    const char* cA = (const char*)g.A + (size_t)cur.pm * tstep; const char* cB = (const char*)g.Bt + (size_t)cur.pn * tstep;
    if constexpr (SP2) {
        PG8_STAGE(PG8_SB(0, 0), cB, voffB); PG8_STAGE(PG8_SB(0, 1), cB + hstepB, voffB); PG8_STAGE(PG8_SA(0, 0), cA, voffA); PG8_STAGE(PG8_SA(0, 1), cA + hstepA, voffA);
        if (wr == 1) PG8_BAR;
        PG8_WAIT_V(2); PG8_BAR;
        PG8_STAGE(PG8_SB(1, 0), cB + kstep, voffB); PG8_STAGE(PG8_SA(1, 0), cA + kstepA, voffA); PG8_STAGE(PG8_SB(1, 1), cB + hstepB + kstep, voffB);
        PG8_WAIT_V(6); PG8_BAR;
    } else {
        PG8_STAGE(PG8_SB(0, 0), cB, voffB); PG8_STAGE(PG8_SA(0, 0), cA, voffA); PG8_STAGE(PG8_SB(0, 1), cB + hstepB, voffB); PG8_STAGE(PG8_SA(0, 1), cA + hstepA, voffA);
        if (wr == 1) PG8_BAR;
        PG8_WAIT_V(4); PG8_BAR;
        PG8_STAGE(PG8_SB(1, 0), cB + kstep, voffB); PG8_STAGE(PG8_SA(1, 0), cA + kstepA, voffA); PG8_STAGE(PG8_SB(1, 1), cB + hstepB + kstep, voffB);
        PG8_WAIT_V(6); PG8_BAR;
    }
    for (;;) {
        const bool has_next = S.next(ui + 1, nxt);
        const char* nA = has_next ? (const char*)g.A + (size_t)nxt.pm * tstep : cA; const char* nB = has_next ? (const char*)g.Bt + (size_t)nxt.pn * tstep : cB;
        for (int t = 0; t < nt; t += 2) {
            const bool last = (t == nt - 2);
            const char* a1 = cA + (size_t)(t + 1) * kstepA;
            const char* a2 = last ? nA : cA + (size_t)(t + 2) * kstepA; const char* b2 = last ? nB : cB + (size_t)(t + 2) * kstep;
            const char* a3 = a2 + kstepA; const char* b3 = b2 + kstep;
            if constexpr (SP2) {
            PG8_LDB(B0, 0, 0); PG8_LDB(B1, 0, 1); PG8_SCHED; PG8_LDA(At, 0, 0); PG8_STAGE(PG8_SA(1, 1), a1 + hstepA, voffA);
            PG8_WAIT_V(8); PG8_WAIT_L(0); PG8_BAR; PG8_MMA(0, 0, At, B0); PG8_MMA(0, 1, At, B1); PG8_BAR; PG8_SCHED;
            PG8_LDA(At, 0, 1); PG8_STAGE(PG8_SB(0, 0), b2, voffB); PG8_STAGE(PG8_SB(0, 1), b2 + hstepB, voffB); PG8_STAGE(PG8_SA(0, 0), a2, voffA);
            PG8_WAIT_V(8); PG8_WAIT_L(0); PG8_BAR; PG8_MMA(1, 0, At, B0); PG8_MMA(1, 1, At, B1); PG8_BAR; PG8_SCHED;
            PG8_LDB(B0, 1, 0); PG8_LDB(B1, 1, 1); PG8_SCHED; PG8_LDA(At, 1, 0); PG8_STAGE(PG8_SA(0, 1), a2 + hstepA, voffA);
            PG8_WAIT_V(8); PG8_WAIT_L(0); PG8_BAR; PG8_MMA(0, 0, At, B0); PG8_MMA(0, 1, At, B1); PG8_BAR; PG8_SCHED;
            PG8_LDA(At, 1, 1); PG8_STAGE(PG8_SB(1, 0), b3, voffB); PG8_STAGE(PG8_SB(1, 1), b3 + hstepB, voffB); PG8_STAGE(PG8_SA(1, 0), a3, voffA);
            PG8_WAIT_V(8); PG8_WAIT_L(0); PG8_BAR; PG8_MMA(1, 0, At, B0); PG8_MMA(1, 1, At, B1); PG8_BAR; PG8_SCHED;
            } else {
            PG8_LDB(B0, 0, 0); PG8_SCHED; PG8_LDA(At, 0, 0); PG8_STAGE(PG8_SA(1, 1), a1 + hstepA, voffA);
            PG8_WAIT_L(8); PG8_BAR; PG8_WAIT_L(0); PG8_MMA(0, 0, At, B0); PG8_BAR; PG8_SCHED;
            PG8_LDB(B1, 0, 1); PG8_STAGE(PG8_SB(0, 0), b2, voffB);
            PG8_BAR; PG8_WAIT_L(0); PG8_MMA(0, 1, At, B1); PG8_BAR;
            PG8_LDA(At, 0, 1); PG8_STAGE(PG8_SA(0, 0), a2, voffA);
            PG8_BAR; PG8_WAIT_L(0); PG8_MMA(1, 0, At, B0); PG8_BAR; PG8_SCHED;
            PG8_STAGE(PG8_SB(0, 1), b2 + hstepB, voffB);
            PG8_WAIT_V(6); PG8_BAR; PG8_MMA(1, 1, At, B1); PG8_BAR;
            PG8_LDB(B0, 1, 0); PG8_SCHED; PG8_LDA(At, 1, 0); PG8_STAGE(PG8_SA(0, 1), a2 + hstepA, voffA);
            PG8_WAIT_L(8); PG8_BAR; PG8_WAIT_L(0); PG8_MMA(0, 0, At, B0); PG8_BAR; PG8_SCHED;
            PG8_LDB(B1, 1, 1); PG8_STAGE(PG8_SB(1, 0), b3, voffB);
            PG8_BAR; PG8_WAIT_L(0); PG8_MMA(0, 1, At, B1); PG8_BAR;
            PG8_LDA(At, 1, 1); PG8_STAGE(PG8_SA(1, 0), a3, voffA);
            PG8_BAR; PG8_WAIT_L(0); PG8_MMA(1, 0, At, B0); PG8_BAR; PG8_SCHED;
            PG8_STAGE(PG8_SB(1, 1), b3 + hstepB, voffB);
            PG8_WAIT_V(6); PG8_BAR; PG8_MMA(1, 1, At, B1); PG8_BAR;
            }
        }
        if constexpr (ALIGN_EPI) { if (wr == 0) PG8_BAR; }
        E(acc, cur, wr, wc, fr, fq);
        if (!has_next) break;
#pragma unroll
        for (int a = 0; a < 2; ++a)
#pragma unroll
            for (int b = 0; b < 2; ++b)
#pragma unroll
                for (int m = 0; m < 4; ++m)
#pragma unroll
                    for (int n = 0; n < 2; ++n) acc[a][b][m][n] = (f32x4){0.f, 0.f, 0.f, 0.f};
        cur = nxt; cA = nA; cB = nB; ++ui;
        if constexpr (ALIGN_EPI) { if (wr == 1) PG8_BAR; }
    }
    PG8_WAIT_V(0);
    if constexpr (!ALIGN_EPI) { if (wr == 0) PG8_BAR; }
    PG8_BAR;
#undef PG8_SA
#undef PG8_SB
#undef PG8_STAGE
#undef PG8_LDA
#undef PG8_LDB
#undef PG8_MMA
#undef PG8_WAIT_V
#undef PG8_WAIT_L
#undef PG8_BAR
#undef PG8_SCHED
}
}

#define LAS __attribute__((address_space(3)))
#define CAS __attribute__((address_space(4)))
typedef unsigned short bf16;
typedef float f32x4 __attribute__((ext_vector_type(4)));
typedef float f32x16 __attribute__((ext_vector_type(16)));
typedef short bf16x8 __attribute__((ext_vector_type(8)));
typedef short s16x4 __attribute__((ext_vector_type(4)));
typedef unsigned u32x4 __attribute__((ext_vector_type(4)));
typedef unsigned u32x2 __attribute__((ext_vector_type(2)));

constexpr int D = 1024, MTOK = 81920, MPROMPT = 65536, MMEM = 8448, FF = 2816;
constexpr int NTILE = MTOK / 256;
constexpr size_t MiB = 1u << 20;
constexpr size_t WS_CTL = 0, CTL_ZERO_BYTES = 131072;
constexpr int CW_PANEL = 4096;
constexpr size_t WS_XS = 110 * MiB + 768 * 1024;
constexpr size_t WS_WINA = 1 * MiB, WS_WINB = 4 * MiB, WS_WMKV = 9 * MiB, WS_WO = 11 * MiB, WS_WGU = 15 * MiB, WS_WD = 37 * MiB;
constexpr size_t WS_SS = 49 * MiB, WS_SSM = 55 * MiB, WS_MB = 56 * MiB, WS_MKV = 73 * MiB, WS_SB = 90 * MiB;
constexpr size_t WS_XB = 112 * MiB, WS_PROJ = 272 * MiB, WS_O = 672 * MiB, WS_ACT = 272 * MiB, WS_END = 832 * MiB;
static_assert(WS_WINA + (size_t)1536 * 1024 * 2 <= WS_WINB && WS_WINB + (size_t)2560 * 1024 * 2 <= WS_WMKV && WS_WMKV + (size_t)1024 * 1024 * 2 <= WS_WO && WS_WO + (size_t)2 * 1024 * 1024 * 2 <= WS_WGU &&
              WS_WGU + (size_t)2 * 5632 * 1024 * 2 <= WS_WD && WS_WD + (size_t)2 * 1024 * 2816 * 2 <= WS_SS && WS_SS + (size_t)MTOK * 16 <= WS_SSM && WS_SSM + (size_t)MMEM * 16 <= WS_MB &&
              WS_MB + (size_t)MMEM * 1024 * 2 <= WS_MKV && WS_MKV + (size_t)MMEM * 1024 * 2 <= WS_SB && WS_SB + (size_t)NTILE * 6 * FF * 4 <= WS_XB && WS_XB + (size_t)MTOK * 1024 * 2 <= WS_PROJ &&
              WS_PROJ + (size_t)MTOK * 2560 * 2 <= WS_O && WS_O + (size_t)MTOK * 1024 * 2 <= WS_END && WS_ACT + (size_t)MTOK * FF * 2 <= WS_END, "d_ws map");

static_assert((CW_PANEL + 64 * 320) * 4 <= (int)CTL_ZERO_BYTES && WS_SB + (size_t)NTILE * 6 * FF * 4 <= WS_XS && WS_XS + (size_t)320 * 4 * 256 * 4 <= WS_XB, "ctl / exchange map");
constexpr int LDS_X_OFF = 131072;
constexpr int MISC_OFF = 131072 + 2 * 17 * 128 * 4 + 512;
constexpr int LDS_BYTES = 131072 + 2 * 17 * 128 * 4 + 1024;
constexpr int NWAVES = 8;

__device__ __forceinline__ unsigned f2bf(float f) { unsigned u = __builtin_bit_cast(unsigned, f); return (u + 0x7fffu + ((u >> 16) & 1u)) >> 16; }
__device__ __forceinline__ unsigned pk2(float lo, float hi) { return f2bf(lo) | (f2bf(hi) << 16); }
__device__ __forceinline__ float wave_sum(float v) {
#pragma unroll
    for (int o = 1; o < 64; o <<= 1) v += __shfl_xor(v, o);
    return v;
}

#define XB_TMO      128
#define XB_XCNT(j)  (256  + 64 * (j))
#define XB_XSUB(j)  (1280 + 64 * (j))
#define XB_XGEN(j)  (2304 + 64 * (j))
#define XB_TOP      3328
#define XB_TOPGEN   3392
#define XCD_BAR_WORDS 3456
#define XB_SPIN_CAP (1u << 22)
__device__ __forceinline__ unsigned xb_ld(unsigned* p)              { return __hip_atomic_load(p, __ATOMIC_RELAXED, __HIP_MEMORY_SCOPE_AGENT); }
__device__ __forceinline__ unsigned xb_add(unsigned* p, unsigned v) { return __hip_atomic_fetch_add(p, v, __ATOMIC_RELAXED, __HIP_MEMORY_SCOPE_AGENT); }
__device__ __forceinline__ unsigned xb_xcc_id() { return (unsigned)__builtin_amdgcn_s_getreg((3 << 11) | 20) & 0xFu; }
#define XB_SPIN(cond, bar) do { unsigned _sp = 0; while (cond) { __builtin_amdgcn_s_sleep(1); \
    if ((++_sp & 255u) == 0u) { if (xb_ld(&(bar)[XB_TMO])) break; if (_sp > XB_SPIN_CAP) { atomicAdd(&(bar)[XB_TMO], 1u); break; } } } } while (0)
__device__ __forceinline__ void xcd_barrier_complete(unsigned* bar, unsigned x, unsigned& nloc, unsigned& nx) {
    const unsigned G = gridDim.x * gridDim.y * gridDim.z;
    unsigned sum, cnt, mine, sp = 0u;
    for (;;) {
        sum = 0u; cnt = 0u; mine = 0u;
#pragma unroll
        for (unsigned j = 0; j < 16; ++j) { const unsigned c = xb_ld(&bar[XB_XCNT(j)]); sum += c; cnt += (c > 0u) ? 1u : 0u; mine = (j == x) ? c : mine; }
        if (sum == G) break;
        __builtin_amdgcn_s_sleep(1);
        if ((++sp & 255u) == 0u) { if (xb_ld(&bar[XB_TMO])) break; if (sp > XB_SPIN_CAP) { atomicAdd(&bar[XB_TMO], 1u); break; } }
    }
    nloc = mine > 0u ? mine : 1u; nx = cnt > 0u ? cnt : 1u;
}
__device__ __forceinline__ void xcd_barrier(unsigned* bar, volatile __attribute__((address_space(3))) unsigned* st) {
    asm volatile("s_waitcnt vmcnt(0)" ::: "memory");
    __syncthreads();
    if (threadIdx.x == 0) {
        const unsigned x = xb_xcc_id();
        __builtin_amdgcn_s_waitcnt(0);
        unsigned nloc = st[0], nx = st[1];
        if (nloc == 0u) { xcd_barrier_complete(bar, x, nloc, nx); st[0] = nloc; st[1] = nx; }
        const unsigned old = xb_add(&bar[XB_XSUB(x)], 1u);
        const unsigned gen = old / nloc;
        if (old + 1u == (gen + 1u) * nloc) {
            __builtin_amdgcn_fence(__ATOMIC_RELEASE, "agent");
            asm volatile("s_waitcnt vmcnt(0)" ::: "memory");
            const unsigned og = xb_add(&bar[XB_TOP], 1u);
            const unsigned tg = og / nx;
            if (og + 1u == (tg + 1u) * nx) xb_add(&bar[XB_TOPGEN], 1u);
            else XB_SPIN(xb_ld(&bar[XB_TOPGEN]) == tg, bar);
            __builtin_amdgcn_fence(__ATOMIC_ACQUIRE, "agent");
            xb_add(&bar[XB_XGEN(x)], 1u);
            asm volatile("s_waitcnt vmcnt(0)" ::: "memory");
        } else {
            XB_SPIN(xb_ld(&bar[XB_XGEN(x)]) == gen, bar);
            __builtin_amdgcn_fence(__ATOMIC_ACQUIRE, "agent");
            asm volatile("s_waitcnt vmcnt(0)" ::: "memory");
        }
    }
    __syncthreads();
}

__device__ __forceinline__ void p0_transpose_item(const float* W, int K, int N, bf16* WT, int row_off, int mode, const float* gain, LAS float* scr, int item, int lane) {
    const int nblk = N / 32, kb = item / nblk, nb = item % nblk, k0 = 64 * kb, n0 = 32 * nb;
#pragma unroll 8
    for (int i = 0; i < 32; ++i) { const int kk = 2 * i + (lane >> 5); float v = W[(size_t)(k0 + kk) * N + n0 + (lane & 31)]; if (gain) v *= gain[k0 + kk]; scr[kk * 33 + (lane & 31)] = v; }
    asm volatile("s_waitcnt lgkmcnt(0)" ::: "memory");
    const int c = lane & 7;
    const int drow0 = (mode == 0) ? row_off + n0 : (n0 / 128) * 256 + ((n0 % 128) / 32) * 64 + (mode - 1) * 32;
#pragma unroll
    for (int j = 0; j < 4; ++j) { const int n = (lane >> 3) + 8 * j; const LAS float* s = scr + (8 * c) * 33 + n;
        u32x4 o; o.x = pk2(s[0 * 33], s[1 * 33]); o.y = pk2(s[2 * 33], s[3 * 33]); o.z = pk2(s[4 * 33], s[5 * 33]); o.w = pk2(s[6 * 33], s[7 * 33]);
        *(u32x4*)(WT + (size_t)(drow0 + n) * K + k0 + 8 * c) = o; }
    asm volatile("s_waitcnt lgkmcnt(0)" ::: "memory");
}
__device__ __forceinline__ void row_to_bf16(const float* xrow, bf16* orow, float* ssrow, int lane) {
    const f32x4* xr = (const f32x4*)xrow + lane;
    f32x4 v[4]; float s = 0.f;
#pragma unroll
    for (int j = 0; j < 4; ++j) { v[j] = xr[64 * j]; s += (v[j].x * v[j].x + v[j].y * v[j].y) + (v[j].z * v[j].z + v[j].w * v[j].w); }
    s = wave_sum(s);
    u32x2* o8 = (u32x2*)orow + lane;
#pragma unroll
    for (int j = 0; j < 4; ++j) { u32x2 w; w.x = pk2(v[j].x, v[j].y); w.y = pk2(v[j].z, v[j].w); o8[64 * j] = w; }
    if (lane == 0) *(f32x4*)ssrow = (f32x4){s, 0.f, 0.f, 0.f};
}

struct Args {
    const float* in[19]; float* out; unsigned char* ws; int ph_lo, ph_hi;
};

constexpr float LOG2E = 1.4426950408889634f;
constexpr float CSC = 0.125f * LOG2E;
#define MFMA32(a, b, c) __builtin_amdgcn_mfma_f32_32x32x16_bf16((a), (b), (c), 0, 0, 0)
__device__ __forceinline__ int crow(int i, int hi) { return (i & 3) + 8 * (i >> 2) + 4 * hi; }

template <int UN> struct VRegs { u32x4 a[UN], b[UN]; };
template <int UN> __device__ __forceinline__ void vt_load(VRegs<UN>& R, const bf16* Vbase, int pitch, int gk0, int kl_lo, int kl_hi) {
    const int npair = (kl_hi - kl_lo) >> 1, total = npair * 8;
#pragma unroll
    for (int uu = 0; uu < UN; ++uu) {
        const int idx = threadIdx.x + uu * NWAVES * 64;
        if (idx < total) {
            const int c = idx / npair, p = idx - c * npair, kl = kl_lo + 2 * p;
            const bf16* src = Vbase + (size_t)(gk0 + kl) * pitch + 8 * c;
            R.a[uu] = *(const u32x4*)src; R.b[uu] = *(const u32x4*)(src + pitch);
        }
    }
}
template <int UN> __device__ __forceinline__ void vt_store(const VRegs<UN>& R, LAS unsigned char* vt, int VS, int kl_lo, int kl_hi) {
    const int npair = (kl_hi - kl_lo) >> 1, total = npair * 8, rs = VS / 2;
#pragma unroll
    for (int uu = 0; uu < UN; ++uu) {
        const int idx = threadIdx.x + uu * NWAVES * 64;
        if (idx < total) {
            const int c = idx / npair, p = idx - c * npair, kl = kl_lo + 2 * p;
            LAS unsigned* dst = (LAS unsigned*)(vt + ((size_t)(8 * c) * VS + kl) * 2);
#pragma unroll
            for (int i = 0; i < 4; ++i) {
                dst[(2 * i) * rs] = (R.a[uu][i] & 0xffffu) | (R.b[uu][i] << 16);
                dst[(2 * i + 1) * rs] = (R.a[uu][i] >> 16) | (R.b[uu][i] & 0xffff0000u);
            }
        }
    }
}
template <int UN> struct KRegs { u32x4 a[UN]; };
template <int UN> __device__ __forceinline__ void kt_load(KRegs<UN>& R, const bf16* Kbase, int pitch, int gk0, int kl_lo, int kl_hi) {
    const int total = (kl_hi - kl_lo) * 8;
#pragma unroll
    for (int uu = 0; uu < UN; ++uu) {
        const int idx = threadIdx.x + uu * NWAVES * 64;
        if (idx < total) { const int kl = kl_lo + (idx >> 3), c = idx & 7; R.a[uu] = *(const u32x4*)(Kbase + (size_t)(gk0 + kl) * pitch + 8 * c); }
    }
}
template <int UN> __device__ __forceinline__ void kt_store(const KRegs<UN>& R, LAS unsigned char* kt, int kl_lo, int kl_hi) {
    const int total = (kl_hi - kl_lo) * 8;
#pragma unroll
    for (int uu = 0; uu < UN; ++uu) {
        const int idx = threadIdx.x + uu * NWAVES * 64;
        if (idx < total) { const int kl = kl_lo + (idx >> 3), c = idx & 7; *(LAS u32x4*)(kt + kl * 128 + ((c ^ ((kl >> 1) & 7)) << 4)) = R.a[uu]; }
    }
}
__device__ __forceinline__ void load_kfrag_lds(bf16x8 (&f)[4], const LAS unsigned char* kt, int kl  , int hi) {
    const LAS unsigned char* p = kt + kl * 128; const int sw = (kl >> 1) & 7;
#pragma unroll
    for (int ks = 0; ks < 4; ++ks) f[ks] = *(const LAS bf16x8*)(p + (((2 * ks + hi) ^ sw) << 4));
}
__device__ __forceinline__ void load_frag4(bf16x8 (&f)[4], const bf16* p) {
#pragma unroll
    for (int ks = 0; ks < 4; ++ks) f[ks] = *(const bf16x8*)(p + 16 * ks);
}
__device__ __forceinline__ void attn_step(f32x16& s, float& m, float& l, f32x16 (&o)[2], const LAS unsigned char* vt, int VSb, int kb0, int lane) {
    float mxa = fmaxf(fmaxf(s[0], s[1]), s[2]), mxb = fmaxf(fmaxf(s[3], s[4]), s[5]);
    mxa = fmaxf(fmaxf(mxa, s[6]), s[7]); mxb = fmaxf(fmaxf(mxb, s[8]), s[9]); mxa = fmaxf(fmaxf(mxa, s[10]), s[11]); mxb = fmaxf(fmaxf(mxb, s[12]), s[13]); mxa = fmaxf(fmaxf(mxa, s[14]), s[15]);
    float mx = fmaxf(mxa, mxb);
    mx = fmaxf(mx, __shfl_xor(mx, 32));
    if (__any(mx > m + 8.0f)) {
        const float mn = fmaxf(m, mx);
        const float corr = __builtin_amdgcn_exp2f(m - mn);
        m = mn; l = l * corr;
#pragma unroll
        for (int d = 0; d < 2; ++d) o[d] = o[d] * corr;
    }
    float sum = 0.f;
#pragma unroll
    for (int i = 0; i < 16; ++i) { s[i] = __builtin_amdgcn_exp2f(s[i] - m); sum += s[i]; }
    sum += __shfl_xor(sum, 32);
    l = l + sum;
    bf16x8 pb[2];
#pragma unroll
    for (int st = 0; st < 2; ++st) {
        u32x4 w; w.x = pg8::cvt_pk_bf16(s[8 * st + 0], s[8 * st + 1]); w.y = pg8::cvt_pk_bf16(s[8 * st + 2], s[8 * st + 3]); w.z = pg8::cvt_pk_bf16(s[8 * st + 4], s[8 * st + 5]); w.w = pg8::cvt_pk_bf16(s[8 * st + 6], s[8 * st + 7]);
        pb[st] = __builtin_bit_cast(bf16x8, w);
    }
    const int dl = lane & 31, hi = lane >> 5;
#pragma unroll
    for (int db = 0; db < 2; ++db)
#pragma unroll
        for (int st = 0; st < 2; ++st) {
            const LAS unsigned char* p = vt + (size_t)(32 * db + dl) * VSb + (size_t)(kb0 + 16 * st + 4 * hi) * 2;
            const s16x4 a0 = *(const LAS s16x4*)p, a1 = *(const LAS s16x4*)(p + 16);
            const bf16x8 a = __builtin_shufflevector(a0, a1, 0, 1, 2, 3, 4, 5, 6, 7);
            o[db] = MFMA32(a, pb[st], o[db]);
        }
}
__device__ __forceinline__ void store_o(const f32x16 (&o)[2], float l, bf16* orow, int hi) {
    const float inv = 1.0f / l;
#pragma unroll
    for (int db = 0; db < 2; ++db)
#pragma unroll
        for (int ig = 0; ig < 4; ++ig) {
            u32x2 w; w.x = pg8::cvt_pk_bf16(o[db][4 * ig] * inv, o[db][4 * ig + 1] * inv); w.y = pg8::cvt_pk_bf16(o[db][4 * ig + 2] * inv, o[db][4 * ig + 3] * inv);
            *(u32x2*)(orow + 32 * db + 8 * ig + 4 * hi) = w;
        }
}
__device__ __forceinline__ void tile_seq(int pm, int& seq, int& jb, int& T, int& seqbase) {
    if (pm < 256) { seq = pm >> 3; jb = pm & 7; T = 2048; seqbase = seq * 2048; } else { seq = 32; jb = pm - 256; T = 16384; seqbase = MPROMPT; }
}

__device__ __forceinline__ void window_chunk(const LAS unsigned char* vt, int VSb, const LAS unsigned char* kt, const bf16x8 (&qf)[4], bf16* O, int seqbase, int T, int jb, int g, int r, int qc, float sink, int lane) {
    const int q = lane & 31, hi = lane >> 5, hq = 3 * g + r, t0 = 256 * jb + 32 * qc, t = t0 + q;
    const float slope2 = exp2f(-8.0f * (float)(hq + 1) / 12.0f) * LOG2E;
    float m = sink * LOG2E, l = 1.0f;
    f32x16 o[2];
#pragma unroll
    for (int i = 0; i < 16; ++i) { o[0][i] = 0.f; o[1][i] = 0.f; }
    const int kb_lo = (t0 / 32 - 4) > 0 ? (t0 / 32 - 4) : 0, kb_hi = (t0 / 32 + 4) < (T / 32 - 1) ? (t0 / 32 + 4) : (T / 32 - 1);
    for (int kb = kb_lo; kb <= kb_hi; ++kb) {
        const int kbl = 32 * kb - 256 * jb + 128;
        bf16x8 kf[4]; load_kfrag_lds(kf, kt, kbl + q, hi);
        f32x16 s;
#pragma unroll
        for (int i = 0; i < 16; ++i) s[i] = 0.f;
#pragma unroll
        for (int ks = 0; ks < 4; ++ks) s = MFMA32(kf[ks], qf[ks], s);
        const float base = (float)(t - 32 * kb - 4 * hi);
        if (kb != t0 / 32) {
            const float ks = (kb < t0 / 32) ? slope2 : -slope2, A = -ks * base;
#pragma unroll
            for (int i = 0; i < 16; ++i) s[i] = fmaf(s[i], CSC, fmaf((float)((i & 3) + 8 * (i >> 2)), ks, A));
        } else {
#pragma unroll
            for (int i = 0; i < 16; ++i) { const float d = base - (float)((i & 3) + 8 * (i >> 2)); s[i] = fmaf(s[i], CSC, -slope2 * fabsf(d)); }
        }
        if (kb == t0 / 32 - 4 || kb == t0 / 32 + 4) {
#pragma unroll
            for (int i = 0; i < 16; ++i) { const float d = base - (float)((i & 3) + 8 * (i >> 2)); if (fabsf(d) > 128.0f) s[i] = -INFINITY; }
        }
        attn_step(s, m, l, o, vt, VSb, kbl, lane);
    }
    store_o(o, l, O + (size_t)(seqbase + t) * 1024 + hq * 64, hi);
}
__device__ __forceinline__ void mem_chunk(const LAS unsigned char* vt, int VSb, const LAS unsigned char* kt, const bf16x8 (&qf)[4], bf16* obase, int row0, int lane) {
    const int q = lane & 31, hi = lane >> 5;
    float m = -1e30f, l = 0.f;
    f32x16 o[2];
#pragma unroll
    for (int i = 0; i < 16; ++i) { o[0][i] = 0.f; o[1][i] = 0.f; }
    for (int kb = 0; kb < 8; ++kb) {
        bf16x8 kf[4]; load_kfrag_lds(kf, kt, 32 * kb + q, hi);
        f32x16 s;
#pragma unroll
        for (int i = 0; i < 16; ++i) s[i] = 0.f;
#pragma unroll
        for (int ks = 0; ks < 4; ++ks) s = MFMA32(kf[ks], qf[ks], s);
#pragma unroll
        for (int i = 0; i < 16; ++i) s[i] = s[i] * CSC;
        attn_step(s, m, l, o, vt, VSb, 32 * kb, lane);
    }
    store_o(o, l, obase + (size_t)(row0 + q) * 1024, hi);
}
__device__ __forceinline__ void na_chunk(const LAS unsigned char* vt, int VSb, const LAS float* rpbL, const bf16* kptr  , bf16* optr  ,
                                         const bf16x8 (&qf)[4], bf16x8 (&kf)[4], bf16x8 (&kf1)[4], int row_q, int c, int col0, int r0q, int kr_lo, int kr_hi, int klo, int lane) {
    const int hi = lane >> 5;
    int c0 = c - 8; c0 = c0 < 0 ? 0 : c0; c0 = c0 > 48 ? 48 : c0;
    float m = -1e30f, l = 0.f;
    f32x16 o[2];
#pragma unroll
    for (int i = 0; i < 16; ++i) { o[0][i] = 0.f; o[1][i] = 0.f; }
    int dcc[16];
#pragma unroll
    for (int ii = 0; ii < 16; ++ii) { const int kc = col0 + crow(ii, hi); dcc[ii] = ((unsigned)(kc - c0) < 16u) ? (kc - c + 15) : 31; }
    bf16x8 kn[4];
    for (int kr = kr_lo; kr <= kr_hi; ++kr) {
        if (kr + 2 <= kr_hi) load_frag4(kn, kptr + (size_t)(kr + 2 - kr_lo) * 64 * 2560);
        f32x16 s;
#pragma unroll
        for (int ii = 0; ii < 16; ++ii) s[ii] = 0.f;
#pragma unroll
        for (int ks = 0; ks < 4; ++ks) s = MFMA32(kf[ks], qf[ks], s);
        const int br = ((unsigned)(kr - r0q) < 8u) ? (kr - row_q + 7) : 15;
        const LAS float* brow = rpbL + br * 32;
#pragma unroll
        for (int ii = 0; ii < 16; ++ii) s[ii] = fmaf(s[ii], CSC, brow[dcc[ii]]);
        attn_step(s, m, l, o, vt, VSb, (kr - klo) * 64 + col0, lane);
#pragma unroll
        for (int ks = 0; ks < 4; ++ks) { kf[ks] = kf1[ks]; kf1[ks] = kn[ks]; }
    }
    store_o(o, l, optr, hi);
}

#define LDS_BARRIER() do { asm volatile("s_waitcnt lgkmcnt(0)" ::: "memory"); __builtin_amdgcn_s_barrier(); asm volatile("" ::: "memory"); } while (0)
constexpr int MEM_KT_OFF = 34816;
__device__ __forceinline__ void mem_units(LAS unsigned char* lds, const bf16* proj, int qpitch, int qcol, const bf16* mkv, int layer, bf16* O, int wave, int lane, int vcu) {
    const int N = NTILE * 4, G = gridDim.x;
    VRegs<2> VR; KRegs<4> KR; bf16x8 qn[4];
    const int ql = (lane & 31), qh = 8 * (lane >> 5);
    if (vcu < N) { const int hm = vcu / NTILE, pm = vcu - hm * NTILE; int seq, jb, T, seqbase; tile_seq(pm, seq, jb, T, seqbase);
        vt_load<2>(VR, mkv + layer * 512 + 256 + hm * 64, 1024, seq * 256, 0, 256); kt_load<4>(KR, mkv + layer * 512 + hm * 64, 1024, seq * 256, 0, 256);
        load_frag4(qn, proj + qcol + hm * 64 + (size_t)(pm * 256 + 32 * wave + ql) * qpitch + qh); }
    for (int u = vcu; u < N; u += G) {
        const int hm = u / NTILE, pm = u - hm * NTILE; int seq, jb, T, seqbase; tile_seq(pm, seq, jb, T, seqbase);
        bf16x8 qf[4];
#pragma unroll
        for (int ks = 0; ks < 4; ++ks) qf[ks] = qn[ks];
        LDS_BARRIER();
        vt_store<2>(VR, lds, 260, 0, 256); kt_store<4>(KR, lds + MEM_KT_OFF, 0, 256);
        LDS_BARRIER();
        const int un = u + G;
        if (un < N) { const int hm2 = un / NTILE, pm2 = un - hm2 * NTILE; int seq2, jb2, T2, sb2; tile_seq(pm2, seq2, jb2, T2, sb2);
            vt_load<2>(VR, mkv + layer * 512 + 256 + hm2 * 64, 1024, seq2 * 256, 0, 256); kt_load<4>(KR, mkv + layer * 512 + hm2 * 64, 1024, seq2 * 256, 0, 256);
            load_frag4(qn, proj + qcol + hm2 * 64 + (size_t)(pm2 * 256 + 32 * wave + ql) * qpitch + qh); }
        mem_chunk(lds, 260 * 2, lds + MEM_KT_OFF, qf, O + 768 + hm * 64, pm * 256 + 32 * wave, lane);
    }
}

#define LOAD_ARGS() \
    const CAS Args* ap_ = (const CAS Args*)__builtin_amdgcn_kernarg_segment_ptr(); asm volatile("" : "+s"(ap_)); \
    unsigned char* ws = ap_->ws; float* out = ap_->out; (void)out; \
    bf16* WinA = (bf16*)(ws + WS_WINA); bf16* WinB = (bf16*)(ws + WS_WINB); bf16* Wmkv = (bf16*)(ws + WS_WMKV); bf16* Wo = (bf16*)(ws + WS_WO); bf16* Wgu = (bf16*)(ws + WS_WGU); bf16* Wd = (bf16*)(ws + WS_WD); \
    float* SS = (float*)(ws + WS_SS); float* SSM = (float*)(ws + WS_SSM); bf16* MB = (bf16*)(ws + WS_MB); bf16* MKV = (bf16*)(ws + WS_MKV); float* SB = (float*)(ws + WS_SB); \
    bf16* XB = (bf16*)(ws + WS_XB); bf16* PROJ = (bf16*)(ws + WS_PROJ); bf16* OB = (bf16*)(ws + WS_O); bf16* ACT = (bf16*)(ws + WS_ACT); \
    (void)WinA; (void)WinB; (void)Wmkv; (void)Wo; (void)Wgu; (void)Wd; (void)SS; (void)SSM; (void)MB; (void)MKV; (void)SB; (void)XB; (void)PROJ; (void)OB; (void)ACT;
#define ARG(k) (ap_->in[k])
template <int layer>
__device__ __forceinline__ void layer_phases(LAS unsigned char* lds, LAS float* ldsx, const int lo, const int hi_ph, const int G, const int bx) {
    int tid = threadIdx.x; asm volatile("" : "+v"(tid));
    const int lane = tid & 63, wave = __builtin_amdgcn_readfirstlane(tid >> 6);
#define IN(k) (lo <= (k) && (k) < hi_ph)
#define SEAM(k) do { if (IN(k) && IN((k) + 1)) { if ((k) == 0) cg::this_grid().sync(); else { const CAS Args* apb_ = (const CAS Args*)__builtin_amdgcn_kernarg_segment_ptr(); asm volatile("" : "+s"(apb_)); xcd_barrier((unsigned*)(apb_->ws + WS_CTL), (volatile LAS unsigned*)(lds + MISC_OFF)); } } } while (0)
        const int pb = 1 + 6 * layer;
        const int NP = layer == 0 ? 1536 : 2560;
        if (IN(pb)) {
            LOAD_ARGS();
            for (int rep = 0; rep < NREP(1); ++rep)
            { pg8::Gemm g{XB, layer == 0 ? WinA : WinB, MTOK, NP, D, 0}; pg8::StaticOrder S; S.init(MTOK, NP, G, bx);
              pg8::EpiScaleBf16 E{PROJ, NP, SS};
              pg8::gemm_phase<pg8::EpiScaleBf16, pg8::StaticOrder>(lds, g, S, E); }
            { pg8::Gemm g{MB, Wmkv + (size_t)layer * 512 * 1024, MMEM, 512, D, 0}; pg8::StaticOrder S; S.init(MMEM, 512, G, (bx + G / 2) % G);
              pg8::EpiScaleBf16 E{MKV + layer * 512, 1024, SSM};
              pg8::gemm_phase<pg8::EpiScaleBf16, pg8::StaticOrder>(lds, g, S, E); }
        }
        SEAM(pb);
        if (IN(pb + 1)) {
            LOAD_ARGS();
            const float* sink_a = ARG(7); const float* rpb_b = ARG(9);
            const int vcu = (G % 8 == 0) ? (bx % 8) * (G / 8) + bx / 8 : bx;
            if (layer == 0) {
                {
                    const int N = NTILE * 4;
                    VRegs<4> VR; KRegs<8> KR; bf16x8 qn[4]; LAS unsigned char* ktw = lds + 69632;
                    if (vcu < N) { const int g = vcu / NTILE, pm = vcu - g * NTILE; int seq, jb, T, seqbase; tile_seq(pm, seq, jb, T, seqbase);
                        const int kl_lo = (jb == 0) ? 128 : 0; int kl_hi = T - 256 * jb + 128; kl_hi = kl_hi > 512 ? 512 : kl_hi;
                        vt_load<4>(VR, PROJ + 1024 + g * 64, 1536, seqbase + 256 * jb - 128, kl_lo, kl_hi); kt_load<8>(KR, PROJ + 768 + g * 64, 1536, seqbase + 256 * jb - 128, kl_lo, kl_hi);
                        { const int c0_ = 3 * wave, r0_ = c0_ >> 3, qc0_ = c0_ & 7; load_frag4(qn, PROJ + (size_t)(seqbase + 256 * jb + 32 * qc0_ + (lane & 31)) * 1536 + (3 * g + r0_) * 64 + 8 * (lane >> 5)); } }
                    for (int u = vcu; u < N; u += G) {
                        const int g = u / NTILE, pm = u - g * NTILE; int seq, jb, T, seqbase; tile_seq(pm, seq, jb, T, seqbase);
                        const int kl_lo = (jb == 0) ? 128 : 0; int kl_hi = T - 256 * jb + 128; kl_hi = kl_hi > 512 ? 512 : kl_hi;
                        LDS_BARRIER();
                        vt_store<4>(VR, lds, 516, kl_lo, kl_hi); kt_store<8>(KR, ktw, kl_lo, kl_hi);
                        LDS_BARRIER();
                        const int un = u + G;
                        if (un < N) { const int g2 = un / NTILE, pm2 = un - g2 * NTILE; int seq2, jb2, T2, sb2; tile_seq(pm2, seq2, jb2, T2, sb2);
                            const int kl_lo2 = (jb2 == 0) ? 128 : 0; int kl_hi2 = T2 - 256 * jb2 + 128; kl_hi2 = kl_hi2 > 512 ? 512 : kl_hi2;
                            vt_load<4>(VR, PROJ + 1024 + g2 * 64, 1536, sb2 + 256 * jb2 - 128, kl_lo2, kl_hi2); kt_load<8>(KR, PROJ + 768 + g2 * 64, 1536, sb2 + 256 * jb2 - 128, kl_lo2, kl_hi2); }
#pragma unroll 1
                        for (int i = 0; i < 3; ++i) { const int cidx = 3 * wave + i, r = cidx >> 3, qc = cidx & 7;
                            bf16x8 qf[4];
#pragma unroll
                            for (int ks = 0; ks < 4; ++ks) qf[ks] = qn[ks];
                            {
                                int u2 = u, i2 = i + 1; if (i2 == 3) { i2 = 0; u2 = u + G; }
                                if (u2 < N) { const int g2 = u2 / NTILE, pm2 = u2 - g2 * NTILE; int seq2, jb2, T2, sb2; tile_seq(pm2, seq2, jb2, T2, sb2);
                                    const int c2 = 3 * wave + i2, r2 = c2 >> 3, qc2 = c2 & 7;
                                    load_frag4(qn, PROJ + (size_t)(sb2 + 256 * jb2 + 32 * qc2 + (lane & 31)) * 1536 + (3 * g2 + r2) * 64 + 8 * (lane >> 5)); }
                            }
                            window_chunk(lds, 516 * 2, ktw, qf, OB, seqbase, T, jb, g, r, qc, sink_a[3 * g + r], lane); }
                    }
                }
                mem_units(lds, PROJ, 1536, 1280, MKV, 0, OB, wave, lane, vcu);
            } else {
                LAS float* rpbL = (LAS float*)(lds + 98304);
                {
                    const int N = NTILE * 12;
                    VRegs<6> VR; float rpbv = 0.f; bf16x8 qn[4], kn0[4];
#define NA_QK(uu_) { NA_DESC(uu_, hq_, jbq_, sbq_, rowsq_, kloq_, khiq_); (void)kloq_; (void)khiq_; const int rpq_ = wave >> 2, aq_ = wave & 3, qq_ = lane & 31, hiq_ = lane >> 5; \
                        const int rAq_ = 4 * jbq_ + 2 * rpq_, rowq_ = rAq_ + (qq_ >> 4), cq_ = 16 * aq_ + (qq_ & 15); int col0q_ = 16 * aq_ - 8; col0q_ = col0q_ < 0 ? 0 : col0q_; col0q_ = col0q_ > 32 ? 32 : col0q_; \
                        int krq_ = rAq_ - 4; krq_ = krq_ < 0 ? 0 : krq_; krq_ = krq_ > rowsq_ - 8 ? rowsq_ - 8 : krq_; \
                        const bf16* kpq_ = PROJ + 768 + hq_ * 64 + 8 * hiq_ + (size_t)(sbq_ + krq_ * 64 + col0q_ + qq_) * 2560; \
                        load_frag4(qn, PROJ + (size_t)(sbq_ + rowq_ * 64 + cq_) * 2560 + hq_ * 64 + 8 * hiq_); load_frag4(kn0, kpq_); }
#define NA_DESC(uu_, h_, jb_, sb_, rows_, klo_, khi_) const int h_ = (uu_) / NTILE; int jb_, sb_, rows_, klo_, khi_; { const int pm_ = (uu_) - h_ * NTILE; int seq_, T_; tile_seq(pm_, seq_, jb_, T_, sb_); rows_ = T_ / 64; \
                        klo_ = 4 * jb_ - 4; klo_ = klo_ < 0 ? 0 : klo_; klo_ = klo_ > rows_ - 8 ? rows_ - 8 : klo_; khi_ = 4 * jb_ + 3 - 4; khi_ = khi_ < 0 ? 0 : khi_; khi_ = khi_ > rows_ - 8 ? rows_ - 8 : khi_; khi_ += 8; }
                    if (vcu < N) { NA_DESC(vcu, h0, jb0, sb0, rows0, klo0, khi0);
                        vt_load<6>(VR, PROJ + 1536 + h0 * 64, 2560, sb0 + klo0 * 64, 0, (khi0 - klo0) * 64); { const int tr = tid >> 5, tc = tid & 31; rpbv = (tr < 15 && tc < 31) ? rpb_b[h0 * 465 + tr * 31 + tc] * LOG2E : -INFINITY; } NA_QK(vcu); }
                    for (int u = vcu; u < N; u += G) {
                        NA_DESC(u, h, jb, seqbase, rows, klo, khi);
                        const int rp = wave >> 2, a = wave & 3, q = lane & 31, hi = lane >> 5;
                        const int rA = 4 * jb + 2 * rp, row_q = rA + (q >> 4), c = 16 * a + (q & 15);
                        int col0 = 16 * a - 8; col0 = col0 < 0 ? 0 : col0; col0 = col0 > 32 ? 32 : col0;
                        int r0q = row_q - 4; r0q = r0q < 0 ? 0 : r0q; r0q = r0q > rows - 8 ? rows - 8 : r0q;
                        int kr_lo = rA - 4; kr_lo = kr_lo < 0 ? 0 : kr_lo; kr_lo = kr_lo > rows - 8 ? rows - 8 : kr_lo;
                        int kr_hi = rA + 1 - 4; kr_hi = kr_hi < 0 ? 0 : kr_hi; kr_hi = kr_hi > rows - 8 ? rows - 8 : kr_hi; kr_hi += 7;
                        const bf16* kptr = PROJ + 768 + h * 64 + 8 * hi + (size_t)(seqbase + kr_lo * 64 + col0 + q) * 2560;
                        bf16x8 qf[4], kf[4], kf1[4];
#pragma unroll
                        for (int ks = 0; ks < 4; ++ks) { qf[ks] = qn[ks]; kf[ks] = kn0[ks]; }
                        load_frag4(kf1, kptr + (size_t)64 * 2560);
                        LDS_BARRIER();
                        vt_store<6>(VR, lds, 708, 0, (khi - klo) * 64);
                        rpbL[tid] = rpbv;
                        LDS_BARRIER();
                        const int un = u + G;
                        if (un < N) { NA_DESC(un, h2, jb2, sb2, rows2, klo2, khi2);
                            vt_load<6>(VR, PROJ + 1536 + h2 * 64, 2560, sb2 + klo2 * 64, 0, (khi2 - klo2) * 64); { const int tr = tid >> 5, tc = tid & 31; rpbv = (tr < 15 && tc < 31) ? rpb_b[h2 * 465 + tr * 31 + tc] * LOG2E : -INFINITY; } NA_QK(un); }
                        na_chunk(lds, 708 * 2, rpbL, kptr, OB + (size_t)(seqbase + row_q * 64 + c) * 1024 + h * 64, qf, kf, kf1, row_q, c, col0, r0q, kr_lo, kr_hi, klo, lane);
                    }
#undef NA_QK
#undef NA_DESC
                }
                mem_units(lds, PROJ, 2560, 2304, MKV, 1, OB, wave, lane, vcu);
            }
        }
        SEAM(pb + 1);
        if (IN(pb + 2)) {
            LOAD_ARGS();
            pg8::Gemm g{OB, Wo + (size_t)layer * 1024 * 1024, MTOK, D, D, 0}; pg8::StaticOrder S; S.init(MTOK, D, G, bx);
            pg8::EpiResid E{XB, SS, ldsx};
            pg8::gemm_phase<pg8::EpiResid, pg8::StaticOrder>(lds, g, S, E);
        }
        SEAM(pb + 2);
        if (IN(pb + 3)) {
            LOAD_ARGS();
            const float* conv_w = ARG(15); const float* conv_b = ARG(16);
            pg8::Gemm g{XB, Wgu + (size_t)layer * 5632 * 1024, MTOK, 5632, D, 0}; pg8::StaticOrder S; S.init(MTOK, 5632, G, bx);
            pg8::EpiGateUp E{ACT, SS, conv_w + (size_t)layer * 3 * FF, conv_b + (size_t)layer * FF, SB, ldsx};
            if (tid < 128) { ldsx[tid] = 0.f; ldsx[(17 + 16) * 128 + tid] = 0.f; }
            __syncthreads();
            for (int rep = 0; rep < NREP(6); ++rep) pg8::gemm_phase<pg8::EpiGateUp, pg8::StaticOrder>(lds, g, S, E);
        }
        SEAM(pb + 3);
        if (IN(pb + 4)) {
            LOAD_ARGS();
            const float* conv_w = ARG(15);
            const float* cw = conv_w + (size_t)layer * 3 * FF;
            for (int idx = bx * (NWAVES * 64) + tid; idx < NTILE * 2 * FF; idx += G * NWAVES * 64) {
                const int col = idx % FF, pw = idx / FF, pm = pw >> 1, which = pw & 1;
                const float part = SB[(size_t)(pw * 3 + 1) * FF + col], uu = SB[(size_t)(pw * 3 + 2) * FF + col];
                const bool seq_start = (pm < 256) ? ((pm & 7) == 0) : (pm == 256);
                const bool seq_end = (pm < 256) ? ((pm & 7) == 7) : (pm == NTILE - 1);
                float c = part;
                if (which == 0) { if (!seq_start) c += cw[col] * SB[(size_t)(((pm - 1) * 2 + 1) * 3) * FF + col]; }
                else { if (!seq_end) c += cw[2 * FF + col] * SB[(size_t)(((pm + 1) * 2) * 3) * FF + col]; }
                const float sg = 1.0f / (1.0f + __builtin_amdgcn_exp2f(-LOG2E * c));
                ACT[pg8::ilv_off(pm * 256 + (which ? 255 : 0), col, FF)] = (bf16)f2bf(c * sg * uu);
            }
        }
        SEAM(pb + 4);
        if (IN(pb + 5)) {
            LOAD_ARGS();
            pg8::Gemm g{ACT, Wd + (size_t)layer * 1024 * FF, MTOK, D, FF, 1}; pg8::StaticOrder S; S.init(MTOK, D, G, bx);
            if constexpr (layer == 0) {
                pg8::EpiResid E{XB, SS, ldsx};
                pg8::gemm_phase<pg8::EpiResid, pg8::StaticOrder>(lds, g, S, E);
            } else {
                pg8::EpiFinal E{XB, out, ARG(18), (float*)(ws + WS_XS), (unsigned*)(ws + WS_CTL) + CW_PANEL, ldsx};
                pg8::gemm_phase<pg8::EpiFinal, pg8::StaticOrder>(lds, g, S, E);
            }
        }
        if constexpr (layer == 0) { SEAM(pb + 5); }
#undef IN
#undef SEAM
}

__global__ void __launch_bounds__(NWAVES * 64, 2) mega_fwd(Args args) {
    extern __shared__ __attribute__((aligned(16))) unsigned char lds_raw[];
    LAS unsigned char* lds = (LAS unsigned char*)lds_raw;
    const int G = gridDim.x, bx = blockIdx.x;
    if (threadIdx.x < 16) ((volatile LAS unsigned*)(lds + MISC_OFF))[threadIdx.x] = 0u;
    __syncthreads();
    { const CAS Args* apc_ = (const CAS Args*)__builtin_amdgcn_kernarg_segment_ptr(); if (apc_->ph_hi - apc_->ph_lo > 1 && threadIdx.x == 0) (void)xb_add((unsigned*)(apc_->ws + WS_CTL) + XB_XCNT(xb_xcc_id()), 1u); }
#define PHASE_TID() int tid = threadIdx.x; asm volatile("" : "+v"(tid)); const int lane = tid & 63, wave = __builtin_amdgcn_readfirstlane(tid >> 6); (void)lane; (void)wave;
    LAS float* ldsx = (LAS float*)(lds + LDS_X_OFF);

    int lo, hi_ph; { const CAS Args* ap0 = (const CAS Args*)__builtin_amdgcn_kernarg_segment_ptr(); lo = ap0->ph_lo; hi_ph = ap0->ph_hi; }
#define IN(k) (lo <= (k) && (k) < hi_ph)
#define SEAM(k) do { if (IN(k) && IN((k) + 1)) { if ((k) == 0) cg::this_grid().sync(); else { const CAS Args* apb_ = (const CAS Args*)__builtin_amdgcn_kernarg_segment_ptr(); asm volatile("" : "+s"(apb_)); xcd_barrier((unsigned*)(apb_->ws + WS_CTL), (volatile LAS unsigned*)(lds + MISC_OFF)); } } } while (0)

    if (IN(0)) {
        LOAD_ARGS(); PHASE_TID();
        const float* x_prompt = ARG(0); const float* x_sample = ARG(1); const float* mem_prompt = ARG(2); const float* mem_sample = ARG(3); const float* g_mix = ARG(4); const float* g_mem = ARG(5);
        const float* w_in_a = ARG(6); const float* w_in_b = ARG(8); const float* w_mem_kv = ARG(10); const float* w_o = ARG(11); const float* g_ffn = ARG(12); const float* w_gate = ARG(13); const float* w_up = ARG(14); const float* w_down = ARG(17);
        LAS float* scr = (LAS float*)(lds + wave * 16384);
        const int gw = bx * NWAVES + wave, NGW = G * NWAVES;
        constexpr int I_INA = 16 * 48, I_INB = 16 * 80, I_MKV = 16 * 16, I_O = 16 * 32, I_G = 16 * 88, I_D = 44 * 32;
        constexpr int NITEMS = I_INA + I_INB + 2 * I_MKV + 2 * I_O + 4 * I_G + 2 * I_D;
        for (int rep = 0; rep < NREP(0); ++rep) {
        for (int it = gw; it < NITEMS; it += NGW) {
            int r = it;
            if (r < I_INA) { p0_transpose_item(w_in_a, 1024, 1536, WinA, 0, 0, g_mix, scr, r, lane); continue; } r -= I_INA;
            if (r < I_INB) { p0_transpose_item(w_in_b, 1024, 2560, WinB, 0, 0, g_mix + 1024, scr, r, lane); continue; } r -= I_INB;
            if (r < 2 * I_MKV) { const int li = r / I_MKV; p0_transpose_item(w_mem_kv + (size_t)li * 1024 * 512, 1024, 512, Wmkv, li * 512, 0, g_mem + li * 1024, scr, r % I_MKV, lane); continue; } r -= 2 * I_MKV;
            if (r < 2 * I_O) { const int li = r / I_O; p0_transpose_item(w_o + (size_t)li * 1024 * 1024, 1024, 1024, Wo + (size_t)li * 1024 * 1024, 0, 0, nullptr, scr, r % I_O, lane); continue; } r -= 2 * I_O;
            if (r < 4 * I_G) { const int li = r / (2 * I_G), rr = r % (2 * I_G), isup = rr / I_G;
                p0_transpose_item((isup ? w_up : w_gate) + (size_t)li * 1024 * FF, 1024, FF, Wgu + (size_t)li * 5632 * 1024, 0, 1 + isup, g_ffn + li * 1024, scr, rr % I_G, lane); continue; } r -= 4 * I_G;
            { const int li = r / I_D; p0_transpose_item(w_down + (size_t)li * FF * 1024, FF, 1024, Wd + (size_t)li * 1024 * FF, 0, 0, nullptr, scr, r % I_D, lane); }
        }
        for (int m = gw; m < MTOK + MMEM; m += NGW) {
            if (m < MTOK) { const float* xr = m < MPROMPT ? x_prompt + (size_t)m * D : x_sample + (size_t)(m - MPROMPT) * D; row_to_bf16(xr, XB + (size_t)m * D, SS + (size_t)m * 4, lane); }
            else { const int mm = m - MTOK; const float* xr = mm < 8192 ? mem_prompt + (size_t)mm * D : mem_sample + (size_t)(mm - 8192) * D; row_to_bf16(xr, MB + (size_t)mm * D, SSM + (size_t)mm * 4, lane); }
        }
        }
    }
    SEAM(0);

    layer_phases<0>(lds, ldsx, lo, hi_ph, G, bx);
    layer_phases<1>(lds, ldsx, lo, hi_ph, G, bx);
#undef IN
#undef SEAM
}

constexpr int N_PHASES = 13;
extern "C" void kernel_launch(void* const* d_in, const int* in_sizes, int n_in, void* d_out, int out_size, void* d_ws, size_t ws_size, hipStream_t stream) {
    static int grid = 0;
    if (grid == 0) {
        if (n_in != 19 || out_size != MTOK * D || ws_size < WS_END) { fprintf(stderr, "kernel_launch: unexpected shapes n_in %d out %d ws %zu\n", n_in, out_size, ws_size); grid = -1; return; }
        int dev = 0, cus = 0, per_cu = 0;
        if (hipGetDevice(&dev) != hipSuccess || hipDeviceGetAttribute(&cus, hipDeviceAttributeMultiprocessorCount, dev) != hipSuccess) { grid = -1; return; }
        if (hipFuncSetAttribute((const void*)mega_fwd, hipFuncAttributeMaxDynamicSharedMemorySize, LDS_BYTES) != hipSuccess) { fprintf(stderr, "kernel_launch: hipFuncSetAttribute failed\n"); grid = -1; return; }
        if (hipOccupancyMaxActiveBlocksPerMultiprocessor(&per_cu, (const void*)mega_fwd, NWAVES * 64, LDS_BYTES) != hipSuccess || per_cu < 1) { fprintf(stderr, "kernel_launch: occupancy query says %d\n", per_cu); per_cu = 1; }
        (void)hipGetLastError();
        grid = cus * 1;
    }
    if (grid < 0) return;
    if (hipMemsetAsync((char*)d_ws + WS_CTL, 0, CTL_ZERO_BYTES, stream) != hipSuccess) { fprintf(stderr, "kernel_launch: memset failed\n"); return; }
    Args a{};
    for (int i = 0; i < 19; ++i) a.in[i] = (const float*)d_in[i];
    a.out = (float*)d_out; a.ws = (unsigned char*)d_ws;
#if MK_ONE_LAUNCH
    a.ph_lo = 0; a.ph_hi = N_PHASES;
    void* kargs[] = {&a};
    hipError_t e = hipLaunchCooperativeKernel((const void*)mega_fwd, dim3(grid), dim3(NWAVES * 64), kargs, LDS_BYTES, stream);
    if (e != hipSuccess) fprintf(stderr, "cooperative launch failed: %s (grid %d)\n", hipGetErrorString(e), grid);
#else
    for (int p = 0; p < N_PHASES; ++p) { a.ph_lo = p; a.ph_hi = p + 1; hipLaunchKernelGGL(mega_fwd, dim3(grid), dim3(NWAVES * 64), LDS_BYTES, stream, a); }
#endif
}
```

```cpp
#include <hip/hip_runtime.h>
#include <hip/hip_cooperative_groups.h>
#include <cstdio>
#include <cstdint>
namespace cg = cooperative_groups;

#ifndef PROBE_REP
#define PROBE_REP 0
#endif
#define NREP(k) (((PROBE_REP >> (k)) & 1) ? 2 : 1)
#ifndef MK_ONE_LAUNCH
#define MK_ONE_LAUNCH 1
#endif

namespace pg8 {
#define PG8_LAS __attribute__((address_space(3)))
typedef unsigned short bf16_t;
typedef short bf16x8 __attribute__((ext_vector_type(8)));
typedef float f32x4 __attribute__((ext_vector_type(4)));
typedef unsigned u32x4 __attribute__((ext_vector_type(4)));
typedef unsigned u32x2 __attribute__((ext_vector_type(2)));
constexpr int BM = 256, BK = 64, HALF = 128, HTB = HALF * BK * 2, STAGE_BYTES = 8 * HTB, NXCD = 8, WGM = 8;

__host__ __device__ __forceinline__ int lds_byte(int r, int c) { const int st = (r >> 4) * 2 + (c >> 5), rr = r & 15, cc = c & 31, ob = rr * 64 + cc * 2; return st * 1024 + (ob ^ (((ob >> 9) & 1) << 5)); }
__host__ __device__ __forceinline__ void stage_rc(int b, int& R, int& C) { const int st = b / 1024, sb = b % 1024, swz = sb ^ (((sb >> 9) & 1) << 5); R = (st >> 1) * 16 + swz / 64; C = (st & 1) * 32 + (swz % 64) / 2; }
__host__ __device__ __forceinline__ int perm32(int rho) { const int n = rho >> 4, i = rho & 15; return 8 * (i >> 2) + 4 * n + (i & 3); }

__host__ __device__ __forceinline__ size_t ilv_off(int r, int k, int K) { return (size_t)(r >> 4) * (16 * (size_t)K) + (size_t)(r & 7) * (2 * (size_t)K) + (size_t)(k >> 5) * 64 + (size_t)((r >> 3) & 1) * 32 + (k & 31); }
struct Unit { int pm, pn; };
struct Gemm { const bf16_t* A; const bf16_t* Bt; int M, N, K, ailv; };

struct StaticOrder {
    int nM, nN, nwg, G, c;
    __host__ __device__ void init(int M, int N, int G_, int c_) { nM = M / BM; nN = N / BM; nwg = nM * nN; G = G_; c = c_; }
    __host__ __device__ bool next(int i, Unit& u) const {
        const long L = (long)i * G + c; if (L >= nwg) return false;
        int wgid = (int)L; { const int q = nwg / NXCD, r = nwg % NXCD, xcd = wgid % NXCD, off = wgid / NXCD; wgid = (xcd < r ? xcd * (q + 1) : r * (q + 1) + (xcd - r) * q) + off; }
        const int nig = WGM * nN, gid = wgid / nig, fm = gid * WGM, gsz = (nM - fm) < WGM ? (nM - fm) : WGM;
        u.pm = fm + ((wgid % nig) % gsz); u.pn = (wgid % nig) / gsz; return true;
    }
};

__device__ __forceinline__ unsigned cvt_pk_bf16(float lo, float hi) { unsigned r; asm volatile("v_cvt_pk_bf16_f32 %0, %1, %2" : "=v"(r) : "v"(lo), "v"(hi)); return r; }
__device__ __forceinline__ float rstd_of(const float* ss, int row) { const f32x4 p = *(const f32x4*)(ss + (size_t)row * 4); return __builtin_amdgcn_rsqf(((p[0] + p[1]) + (p[2] + p[3])) * (1.0f / 1024.0f) + 1e-6f); }


__device__ __forceinline__ u32x4 xchg8(const u32x4 v) {
    u32x4 r;
#pragma unroll
    for (int i = 0; i < 4; ++i) r[i] = (unsigned)__builtin_amdgcn_update_dpp(0, (int)v[i], 0x128, 0xf, 0xf, true);
    return r;
}
__device__ __forceinline__ u32x4 sel4(bool c, const u32x4 a, const u32x4 b) { u32x4 r; r.x = c ? a.x : b.x; r.y = c ? a.y : b.y; r.z = c ? a.z : b.z; r.w = c ? a.w : b.w; return r; }

struct EpiScaleBf16 {
    static constexpr bool PERM = true;
    bf16_t* O; int ldc; const float* ss;
    __device__ __forceinline__ void operator()(f32x4 (&acc)[2][2][4][2], const Unit& u, int wr, int wc, int fr, int fq) const {
        asm volatile("" : "+v"(fr), "+v"(fq)); asm volatile("" : "+s"(wr), "+s"(wc));
        const bool lo = fr < 8;
        const int row0 = u.pm * BM + wr * 64 + fr, col0 = u.pn * BM + wc * 64 + 8 * fq;
        bf16_t* base = O + (size_t)(u.pm * BM + wr * 64 + (fr & 7)) * ldc + col0 + (lo ? 0 : 32);
#pragma unroll
        for (int ai = 0; ai < 2; ++ai)
#pragma unroll
            for (int m = 0; m < 4; ++m) {
                const float rs = rstd_of(ss, row0 + ai * HALF + m * 16);
                u32x4 w[2];
#pragma unroll
                for (int bj = 0; bj < 2; ++bj) { const f32x4 v0 = acc[ai][bj][m][0] * rs, v1 = acc[ai][bj][m][1] * rs;
                    w[bj].x = cvt_pk_bf16(v0[0], v0[1]); w[bj].y = cvt_pk_bf16(v0[2], v0[3]); w[bj].z = cvt_pk_bf16(v1[0], v1[1]); w[bj].w = cvt_pk_bf16(v1[2], v1[3]); }
                const u32x4 y = xchg8(sel4(lo, w[1], w[0]));
                bf16_t* rp = base + (size_t)(ai * HALF + m * 16) * ldc;
                *(u32x4*)rp = sel4(lo, w[0], y);
                *(u32x4*)(rp + (size_t)8 * ldc) = sel4(lo, y, w[1]);
            }
    }
};

__device__ __forceinline__ f32x4 bf_lo4(unsigned w0, unsigned w1) { return (f32x4){__builtin_bit_cast(float, w0 << 16), __builtin_bit_cast(float, w0 & 0xffff0000u), __builtin_bit_cast(float, w1 << 16), __builtin_bit_cast(float, w1 & 0xffff0000u)}; }
struct EpiResid {
    static constexpr bool PERM = true;
    bf16_t* xb; float* ss; PG8_LAS float* red;
    __device__ __forceinline__ void operator()(f32x4 (&acc)[2][2][4][2], const Unit& u, int wr, int wc, int fr, int fq) const {
        asm volatile("" : "+v"(fr), "+v"(fq)); asm volatile("" : "+s"(wr), "+s"(wc));
        const bool lo = fr < 8;
        const int col0 = u.pn * BM + wc * 64 + 8 * fq;
        bf16_t* base = xb + (size_t)(u.pm * BM + wr * 64 + (fr & 7)) * 1024 + col0 + (lo ? 0 : 32);
#pragma unroll
        for (int ai = 0; ai < 2; ++ai)
#pragma unroll
            for (int m = 0; m < 4; ++m) {
                const int rl = ai * HALF + wr * 64 + m * 16 + fr;
                bf16_t* rp = base + (size_t)(ai * HALF + m * 16) * 1024;
                const u32x4 la = *(const u32x4*)rp, lb = *(const u32x4*)(rp + (size_t)8 * 1024);
                const u32x4 yi = xchg8(sel4(lo, lb, la));
                u32x4 xo[2]; xo[0] = sel4(lo, la, yi); xo[1] = sel4(lo, yi, lb);
                float sq = 0.f; u32x4 w[2];
#pragma unroll
                for (int bj = 0; bj < 2; ++bj) {
                    const f32x4 v0 = acc[ai][bj][m][0] + bf_lo4(xo[bj].x, xo[bj].y), v1 = acc[ai][bj][m][1] + bf_lo4(xo[bj].z, xo[bj].w);
                    sq += (v0[0] * v0[0] + v0[1] * v0[1]) + (v0[2] * v0[2] + v0[3] * v0[3]) + (v1[0] * v1[0] + v1[1] * v1[1]) + (v1[2] * v1[2] + v1[3] * v1[3]);
                    w[bj].x = cvt_pk_bf16(v0[0], v0[1]); w[bj].y = cvt_pk_bf16(v0[2], v0[3]); w[bj].z = cvt_pk_bf16(v1[0], v1[1]); w[bj].w = cvt_pk_bf16(v1[2], v1[3]);
                }
                const u32x4 yo = xchg8(sel4(lo, w[1], w[0]));
                *(u32x4*)rp = sel4(lo, w[0], yo); *(u32x4*)(rp + (size_t)8 * 1024) = sel4(lo, yo, w[1]);
                sq += __shfl_xor(sq, 16); sq += __shfl_xor(sq, 32);
                if (fq == 0) red[rl * 4 + wc] = sq;
            }
        asm volatile("s_waitcnt lgkmcnt(0)" ::: "memory"); __builtin_amdgcn_s_barrier(); asm volatile("" ::: "memory");
        const int tid = threadIdx.x;
        if (tid < 256) { const f32x4 p = *(const PG8_LAS f32x4*)(red + tid * 4); ss[(size_t)(u.pm * BM + tid) * 4 + u.pn] = (p[0] + p[1]) + (p[2] + p[3]); }
    }
};

struct EpiFinal {
    static constexpr bool PERM = true;
    const bf16_t* xb; float* xout; const float* gfin; float* xs; unsigned* cnt; PG8_LAS float* red;
    __device__ __forceinline__ void operator()(f32x4 (&acc)[2][2][4][2], const Unit& u, int wr, int wc, int fr, int fq) const {
        asm volatile("" : "+v"(fr), "+v"(fq)); asm volatile("" : "+s"(wr), "+s"(wc));
        const bool lo = fr < 8;
        const int col0 = u.pn * BM + wc * 64 + 8 * fq;
#pragma unroll
        for (int ai = 0; ai < 2; ++ai)
#pragma unroll
            for (int m = 0; m < 4; ++m) {
                const int rl = ai * HALF + wr * 64 + m * 16 + fr;
                const bf16_t* rp = xb + (size_t)(u.pm * BM + wr * 64 + (fr & 7) + ai * HALF + m * 16) * 1024 + col0 + (lo ? 0 : 32);
                const u32x4 la = *(const u32x4*)rp, lb = *(const u32x4*)(rp + (size_t)8 * 1024);
                const u32x4 yi = xchg8(sel4(lo, lb, la));
                u32x4 xo2[2]; xo2[0] = sel4(lo, la, yi); xo2[1] = sel4(lo, yi, lb);
                float sq = 0.f;
#pragma unroll
                for (int bj = 0; bj < 2; ++bj) {
                    const u32x4 xo = xo2[bj];
                    const f32x4 v0 = acc[ai][bj][m][0] + bf_lo4(xo.x, xo.y), v1 = acc[ai][bj][m][1] + bf_lo4(xo.z, xo.w);
                    sq += (v0[0] * v0[0] + v0[1] * v0[1]) + (v0[2] * v0[2] + v0[3] * v0[3]) + (v1[0] * v1[0] + v1[1] * v1[1]) + (v1[2] * v1[2] + v1[3] * v1[3]);
                    acc[ai][bj][m][0] = v0; acc[ai][bj][m][1] = v1;
                }
                sq += __shfl_xor(sq, 16); sq += __shfl_xor(sq, 32);
                if (fq == 0) red[rl * 4 + wc] = sq;
            }
        asm volatile("s_waitcnt lgkmcnt(0)" ::: "memory"); __builtin_amdgcn_s_barrier(); asm volatile("" ::: "memory");
        const int tid = threadIdx.x;
        unsigned* cw_ = cnt + 64 * u.pm;
        if (tid < 256) {
            const f32x4 p = *(const PG8_LAS f32x4*)(red + tid * 4);
            __hip_atomic_store(xs + (size_t)(u.pm * 4 + u.pn) * 256 + tid, (p[0] + p[1]) + (p[2] + p[3]), __ATOMIC_RELAXED, __HIP_MEMORY_SCOPE_AGENT);
            asm volatile("s_waitcnt vmcnt(0)" ::: "memory");
            if ((tid & 63) == 0) __hip_atomic_fetch_add(cw_, 1u, __ATOMIC_RELAXED, __HIP_MEMORY_SCOPE_AGENT);
        }
        if (tid < 64) {
            unsigned sp = 0u;
            while ((unsigned)__builtin_amdgcn_readfirstlane(__hip_atomic_load(cw_, __ATOMIC_RELAXED, __HIP_MEMORY_SCOPE_AGENT)) < 16u) { __builtin_amdgcn_s_sleep(2); if (++sp > (1u << 24)) break; }
            __builtin_amdgcn_fence(__ATOMIC_ACQUIRE, "agent");
        }
        asm volatile("s_waitcnt vmcnt(0) lgkmcnt(0)" ::: "memory"); __builtin_amdgcn_s_barrier(); asm volatile("" ::: "memory");
        if (tid < 256) {
            const float* xp = xs + (size_t)(u.pm * 4) * 256 + tid;
            const float t0 = __hip_atomic_load(xp, __ATOMIC_RELAXED, __HIP_MEMORY_SCOPE_AGENT), t1 = __hip_atomic_load(xp + 256, __ATOMIC_RELAXED, __HIP_MEMORY_SCOPE_AGENT),
                        t2 = __hip_atomic_load(xp + 512, __ATOMIC_RELAXED, __HIP_MEMORY_SCOPE_AGENT), t3 = __hip_atomic_load(xp + 768, __ATOMIC_RELAXED, __HIP_MEMORY_SCOPE_AGENT);
            red[1024 + tid] = __builtin_amdgcn_rsqf(((t0 + t1) + (t2 + t3)) * (1.0f / 1024.0f) + 1e-6f);
        }
        asm volatile("s_waitcnt lgkmcnt(0)" ::: "memory"); __builtin_amdgcn_s_barrier(); asm volatile("" ::: "memory");
        f32x4 gv[2][2];
#pragma unroll
        for (int bj = 0; bj < 2; ++bj) { gv[bj][0] = *(const f32x4*)(gfin + col0 + bj * 32); gv[bj][1] = *(const f32x4*)(gfin + col0 + bj * 32 + 4); }
#pragma unroll
        for (int ai = 0; ai < 2; ++ai)
#pragma unroll
            for (int m = 0; m < 4; ++m) {
                const int rl = ai * HALF + wr * 64 + m * 16 + fr;
                const float rs = red[1024 + rl];
                float* xo = xout + (size_t)(u.pm * BM + wr * 64 + (fr & 7) + ai * HALF + m * 16) * 1024 + col0 + (lo ? 0 : 4);
#pragma unroll
                for (int bj = 0; bj < 2; ++bj) {
                    const f32x4 w0 = acc[ai][bj][m][0] * rs * gv[bj][0], w1 = acc[ai][bj][m][1] * rs * gv[bj][1];
                    const u32x4 u0 = __builtin_bit_cast(u32x4, w0), u1 = __builtin_bit_cast(u32x4, w1);
                    const u32x4 y = xchg8(sel4(lo, u1, u0));
                    *(u32x4*)(xo + bj * 32) = sel4(lo, u0, y);
                    *(u32x4*)(xo + (size_t)8 * 1024 + bj * 32) = sel4(lo, y, u1);
                }
            }
    }
};

struct EpiGateUp {
    static constexpr bool PERM = true;
    bf16_t* act; const float* ss; const float* cw; const float* cb; float* sb; PG8_LAS float* edge;
    __device__ __forceinline__ void operator()(f32x4 (&acc)[2][2][4][2], const Unit& u, int wr, int wc, int fr, int fq) const {
        asm volatile("" : "+v"(fr), "+v"(fq)); asm volatile("" : "+s"(wr), "+s"(wc));
        const int slot0 = wc * 32 + 8 * fq, fcol0 = u.pn * 128 + slot0;
#pragma unroll
        for (int ai = 0; ai < 2; ++ai)
#pragma unroll
            for (int m = 0; m < 4; ++m) {
                const float rs = rstd_of(ss, u.pm * BM + ai * HALF + wr * 64 + m * 16 + fr);
#pragma unroll
                for (int bj = 0; bj < 2; ++bj)
#pragma unroll
                    for (int n = 0; n < 2; ++n) acc[ai][bj][m][n] = acc[ai][bj][m][n] * rs;
            }
        PG8_LAS float* eB = edge + slot0, * eT = edge + 17 * 128 + slot0;
        if (fr == 0 || fr == 15) {
            PG8_LAS float* e0 = (fr == 15 ? eB + 128 : eT) + wr * 4 * 128;
#pragma unroll
            for (int ai = 0; ai < 2; ++ai)
#pragma unroll
                for (int m = 0; m < 4; ++m) { *(PG8_LAS f32x4*)(e0 + (ai * 8 + m) * 128) = acc[ai][0][m][0]; *(PG8_LAS f32x4*)(e0 + (ai * 8 + m) * 128 + 4) = acc[ai][0][m][1]; }
        }
        asm volatile("s_waitcnt lgkmcnt(0)" ::: "memory"); __builtin_amdgcn_s_barrier(); asm volatile("" ::: "memory");
        const PG8_LAS float* rB = eB + wr * 4 * 128, * rT = eT + (wr * 4 + 1) * 128;
        const int rowb = u.pm * BM + wr * 64 + fr;
        u32x2 keep[2][4];
#pragma unroll
        for (int n = 0; n < 2; ++n) {
            const f32x4 w0 = *(const f32x4*)(cw + fcol0 + 4 * n), w1 = *(const f32x4*)(cw + 2816 + fcol0 + 4 * n), w2 = *(const f32x4*)(cw + 5632 + fcol0 + 4 * n), bb = *(const f32x4*)(cb + fcol0 + 4 * n);
#pragma unroll
            for (int ai = 0; ai < 2; ++ai)
#pragma unroll
                for (int m = 0; m < 4; ++m) {
                    const f32x4 ep = *(const PG8_LAS f32x4*)(rB + (ai * 8 + m) * 128 + 4 * n), en = *(const PG8_LAS f32x4*)(rT + (ai * 8 + m) * 128 + 4 * n);
                    f32x4 cv, av;
#pragma unroll
                    for (int e = 0; e < 4; ++e) {
                        const float g = acc[ai][0][m][n][e];
                        const float up = __builtin_bit_cast(float, __builtin_amdgcn_update_dpp(0, __builtin_bit_cast(int, g), 0x111, 0xf, 0xf, true));
                        const float dn = __builtin_bit_cast(float, __builtin_amdgcn_update_dpp(0, __builtin_bit_cast(int, g), 0x101, 0xf, 0xf, true));
                        const float prev = (fr == 0) ? ep[e] : up, next = (fr == 15) ? en[e] : dn;
                        const float c = w0[e] * prev + w1[e] * g + w2[e] * next + bb[e];
                        const float sg = __builtin_amdgcn_rcpf(1.0f + __builtin_amdgcn_exp2f(-1.4426950408889634f * c));
                        cv[e] = c; av[e] = c * sg * acc[ai][1][m][n][e];
                    }
                    const bool seam = (ai == 0 && m == 0) ? (wr == 0 && fr == 0) : ((ai == 1 && m == 3) ? (wr == 1 && fr == 15) : false);
                    if (seam) {
                        float* s = sb + (size_t)((u.pm * 2 + ai) * 3) * 2816 + fcol0 + 4 * n;
                        *(f32x4*)(s) = acc[ai][0][m][n]; *(f32x4*)(s + 2816) = cv; *(f32x4*)(s + 5632) = acc[ai][1][m][n];
                    }
                    {
                        u32x2 w; w.x = cvt_pk_bf16(av[0], av[1]); w.y = cvt_pk_bf16(av[2], av[3]);
                        if (n == 0) keep[ai][m] = w;
                        else if (!seam) { u32x4 w4; w4.x = keep[ai][m].x; w4.y = keep[ai][m].y; w4.z = w.x; w4.w = w.y; *(u32x4*)(act + ilv_off(rowb + ai * HALF + m * 16, fcol0, 2816)) = w4; }
                    }
                }
        }
    }
};

template <class Epi, class Sched, bool ALIGN_EPI = true, bool SP2 = true>
__device__ __forceinline__ void gemm_phase(PG8_LAS unsigned char* lds, const Gemm g, const Sched& S, const Epi& E) {
    int tid = threadIdx.x; asm volatile("" : "+v"(tid));
    const int wid = __builtin_amdgcn_readfirstlane(tid >> 6), lane = tid & 63, wr = wid >> 2, wc = wid & 3, fr = lane & 15, fq = lane >> 4;
    const int K = g.K, nt = K / BK;
    unsigned voffA[2], voffB[2];
#pragma unroll
    for (int i = 0; i < 2; ++i) { int R, C; stage_rc(tid * 16 + i * 8192, R, C); const int Rb = Epi::PERM ? (64 * (R >> 5) + perm32(R & 31)) : R;
        voffA[i] = g.ailv ? (unsigned)ilv_off(R, C, K) * 2u : (unsigned)(R * K + C) * 2u; voffB[i] = (unsigned)(Rb * K + C) * 2u; }
    const size_t kstep = (size_t)(BK * 2), kstepA = g.ailv ? 2 * kstep : kstep;
    const size_t hstepA = (size_t)HALF * K * 2, hstepB = (size_t)32 * K * 2;
    const size_t tstep = 2 * hstepA;
    const unsigned ldsw = (unsigned)wid * 1024u;
    const int aoff = lds_byte(wr * 64 + fr, fq * 8), boff = lds_byte(wc * 32 + fr, fq * 8);
#define PG8_SA(b, h) (((b) * 2 + (h)) * HTB)
#define PG8_SB(b, h) ((4 + (b) * 2 + (h)) * HTB)
#define PG8_STAGE(bufoff, gbase, voff) do { _Pragma("unroll") for (int _i = 0; _i < 2; ++_i) \
        __builtin_amdgcn_global_load_lds((const unsigned*)((const char*)(gbase) + (voff)[_i]), (PG8_LAS unsigned*)(lds + (bufoff) + ldsw + _i * 8192), 16, 0, 0); } while (0)
#define PG8_LDA(dst, b, h) do { _Pragma("unroll") for (int m = 0; m < 4; ++m) _Pragma("unroll") for (int k = 0; k < 2; ++k) dst[m][k] = *(const PG8_LAS bf16x8*)(lds + PG8_SA(b, h) + aoff + m * 2048 + k * 1024); } while (0)
#define PG8_LDB(dst, b, h) do { _Pragma("unroll") for (int n = 0; n < 2; ++n) _Pragma("unroll") for (int k = 0; k < 2; ++k) dst[n][k] = *(const PG8_LAS bf16x8*)(lds + PG8_SB(b, h) + boff + n * 2048 + k * 1024); } while (0)
#define PG8_MMA(ai, bj, At, Bt) do { __builtin_amdgcn_s_setprio(1); _Pragma("unroll") for (int m = 0; m < 4; ++m) _Pragma("unroll") for (int n = 0; n < 2; ++n) _Pragma("unroll") for (int k = 0; k < 2; ++k) \
        acc[ai][bj][m][n] = __builtin_amdgcn_mfma_f32_16x16x32_bf16(Bt[n][k], At[m][k], acc[ai][bj][m][n], 0, 0, 0); __builtin_amdgcn_s_setprio(0); } while (0)
#define PG8_WAIT_V(n) asm volatile("s_waitcnt vmcnt(" #n ")" ::: "memory")
#define PG8_WAIT_L(n) asm volatile("s_waitcnt lgkmcnt(" #n ")" ::: "memory")
#define PG8_BAR __builtin_amdgcn_s_barrier()
#define PG8_SCHED __builtin_amdgcn_sched_barrier(0)
    Unit cur, nxt; int ui = 0;
    if (!S.next(0, cur)) return;
    f32x4 acc[2][2][4][2];
#pragma unroll
    for (int a = 0; a < 2; ++a)
#pragma unroll
        for (int b = 0; b < 2; ++b)
#pragma unroll
            for (int m = 0; m < 4; ++m)
#pragma unroll
                for (int n = 0; n < 2; ++n) acc[a][b][m][n] = (f32x4){0.f, 0.f, 0.f, 0.f};
    bf16x8 At[4][2], B0[2][2], B1[2][2];
    const char* cA = (const char*)g.A + (size_t)cur.pm * tstep; const char* cB = (const char*)g.Bt + (size_t)cur.pn * tstep;
    if constexpr (SP2) {
        PG8_STAGE(PG8_SB(0, 0), cB, voffB); PG8_STAGE(PG8_SB(0, 1), cB + hstepB, voffB); PG8_STAGE(PG8_SA(0, 0), cA, voffA); PG8_STAGE(PG8_SA(0, 1), cA + hstepA, voffA);
        if (wr == 1) PG8_BAR;
        PG8_WAIT_V(2); PG8_BAR;
        PG8_STAGE(PG8_SB(1, 0), cB + kstep, voffB); PG8_STAGE(PG8_SA(1, 0), cA + kstepA, voffA); PG8_STAGE(PG8_SB(1, 1), cB + hstepB + kstep, voffB);
        PG8_WAIT_V(6); PG8_BAR;
    } else {
        PG8_STAGE(PG8_SB(0, 0), cB, voffB); PG8_STAGE(PG8_SA(0, 0), cA, voffA); PG8_STAGE(PG8_SB(0, 1), cB + hstepB, voffB); PG8_STAGE(PG8_SA(0, 1), cA + hstepA, voffA);
        if (wr == 1) PG8_BAR;
        PG8_WAIT_V(4); PG8_BAR;
        PG8_STAGE(PG8_SB(1, 0), cB + kstep, voffB); PG8_STAGE(PG8_SA(1, 0), cA + kstepA, voffA); PG8_STAGE(PG8_SB(1, 1), cB + hstepB + kstep, voffB);
        PG8_WAIT_V(6); PG8_BAR;
    }
    for (;;) {
        const bool has_next = S.next(ui + 1, nxt);
        const char* nA = has_next ? (const char*)g.A + (size_t)nxt.pm * tstep : cA; const char* nB = has_next ? (const char*)g.Bt + (size_t)nxt.pn * tstep : cB;
        for (int t = 0; t < nt; t += 2) {
            const bool last = (t == nt - 2);
            const char* a1 = cA + (size_t)(t + 1) * kstepA;
            const char* a2 = last ? nA : cA + (size_t)(t + 2) * kstepA; const char* b2 = last ? nB : cB + (size_t)(t + 2) * kstep;
            const char* a3 = a2 + kstepA; const char* b3 = b2 + kstep;
            if constexpr (SP2) {
            PG8_LDB(B0, 0, 0); PG8_LDB(B1, 0, 1); PG8_SCHED; PG8_LDA(At, 0, 0); PG8_STAGE(PG8_SA(1, 1), a1 + hstepA, voffA);
            PG8_WAIT_V(8); PG8_WAIT_L(0); PG8_BAR; PG8_MMA(0, 0, At, B0); PG8_MMA(0, 1, At, B1); PG8_BAR; PG8_SCHED;
            PG8_LDA(At, 0, 1); PG8_STAGE(PG8_SB(0, 0), b2, voffB); PG8_STAGE(PG8_SB(0, 1), b2 + hstepB, voffB); PG8_STAGE(PG8_SA(0, 0), a2, voffA);
            PG8_WAIT_V(8); PG8_WAIT_L(0); PG8_BAR; PG8_MMA(1, 0, At, B0); PG8_MMA(1, 1, At, B1); PG8_BAR; PG8_SCHED;
            PG8_LDB(B0, 1, 0); PG8_LDB(B1, 1, 1); PG8_SCHED; PG8_LDA(At, 1, 0); PG8_STAGE(PG8_SA(0, 1), a2 + hstepA, voffA);
            PG8_WAIT_V(8); PG8_WAIT_L(0); PG8_BAR; PG8_MMA(0, 0, At, B0); PG8_MMA(0, 1, At, B1); PG8_BAR; PG8_SCHED;
            PG8_LDA(At, 1, 1); PG8_STAGE(PG8_SB(1, 0), b3, voffB); PG8_STAGE(PG8_SB(1, 1), b3 + hstepB, voffB); PG8_STAGE(PG8_SA(1, 0), a3, voffA);
            PG8_WAIT_V(8); PG8_WAIT_L(0); PG8_BAR; PG8_MMA(1, 0, At, B0); PG8_MMA(1, 1, At, B1); PG8_BAR; PG8_SCHED;
            } else {
            PG8_LDB(B0, 0, 0); PG8_SCHED; PG8_LDA(At, 0, 0); PG8_STAGE(PG8_SA(1, 1), a1 + hstepA, voffA);
            PG8_WAIT_L(8); PG8_BAR; PG8_WAIT_L(0); PG8_MMA(0, 0, At, B0); PG8_BAR; PG8_SCHED;
            PG8_LDB(B1, 0, 1); PG8_STAGE(PG8_SB(0, 0), b2, voffB);
            PG8_BAR; PG8_WAIT_L(0); PG8_MMA(0, 1, At, B1); PG8_BAR;
            PG8_LDA(At, 0, 1); PG8_STAGE(PG8_SA(0, 0), a2, voffA);
            PG8_BAR; PG8_WAIT_L(0); PG8_MMA(1, 0, At, B0); PG8_BAR; PG8_SCHED;
            PG8_STAGE(PG8_SB(0, 1), b2 + hstepB, voffB);
            PG8_WAIT_V(6); PG8_BAR; PG8_MMA(1, 1, At, B1); PG8_BAR;
            PG8_LDB(B0, 1, 0); PG8_SCHED; PG8_LDA(At, 1, 0); PG8_STAGE(PG8_SA(0, 1), a2 + hstepA, voffA);
            PG8_WAIT_L(8); PG8_BAR; PG8_WAIT_L(0); PG8_MMA(0, 0, At, B0); PG8_BAR; PG8_SCHED;
            PG8_LDB(B1, 1, 1); PG8_STAGE(PG8_SB(1, 0), b3, voffB);
            PG8_BAR; PG8_WAIT_L(0); PG8_MMA(0, 1, At, B1); PG8_BAR;
            PG8_LDA(At, 1, 1); PG8_STAGE(PG8_SA(1, 0), a3, voffA);
            PG8_BAR; PG8_WAIT_L(0); PG8_MMA(1, 0, At, B0); PG8_BAR; PG8_SCHED;
            PG8_STAGE(PG8_SB(1, 1), b3 + hstepB, voffB);
            PG8_WAIT_V(6); PG8_BAR; PG8_MMA(1, 1, At, B1); PG8_BAR;
            }
        }
        if constexpr (ALIGN_EPI) { if (wr == 0) PG8_BAR; }
        E(acc, cur, wr, wc, fr, fq);
        if (!has_next) break;
#pragma unroll
        for (int a = 0; a < 2; ++a)
#pragma unroll
            for (int b = 0; b < 2; ++b)
#pragma unroll
                for (int m = 0; m < 4; ++m)
#pragma unroll
                    for (int n = 0; n < 2; ++n) acc[a][b][m][n] = (f32x4){0.f, 0.f, 0.f, 0.f};
        cur = nxt; cA = nA; cB = nB; ++ui;
        if constexpr (ALIGN_EPI) { if (wr == 1) PG8_BAR; }
    }
    PG8_WAIT_V(0);
    if constexpr (!ALIGN_EPI) { if (wr == 0) PG8_BAR; }
    PG8_BAR;
#undef PG8_SA
#undef PG8_SB
#undef PG8_STAGE
#undef PG8_LDA
#undef PG8_LDB
#undef PG8_MMA
#undef PG8_WAIT_V
#undef PG8_WAIT_L
#undef PG8_BAR
#undef PG8_SCHED
}
}

#define LAS __attribute__((address_space(3)))
#define CAS __attribute__((address_space(4)))
typedef unsigned short bf16;
typedef float f32x4 __attribute__((ext_vector_type(4)));
typedef float f32x16 __attribute__((ext_vector_type(16)));
typedef short bf16x8 __attribute__((ext_vector_type(8)));
typedef short s16x4 __attribute__((ext_vector_type(4)));
typedef unsigned u32x4 __attribute__((ext_vector_type(4)));
typedef unsigned u32x2 __attribute__((ext_vector_type(2)));

constexpr int D = 1024, MTOK = 81920, MPROMPT = 65536, MMEM = 8448, FF = 2816;
constexpr int NTILE = MTOK / 256;
constexpr size_t MiB = 1u << 20;
constexpr size_t WS_CTL = 0, CTL_ZERO_BYTES = 131072;
constexpr int CW_PANEL = 4096;
constexpr size_t WS_XS = 110 * MiB + 768 * 1024;
constexpr size_t WS_WINA = 1 * MiB, WS_WINB = 4 * MiB, WS_WMKV = 9 * MiB, WS_WO = 11 * MiB, WS_WGU = 15 * MiB, WS_WD = 37 * MiB;
constexpr size_t WS_SS = 49 * MiB, WS_SSM = 55 * MiB, WS_MB = 56 * MiB, WS_MKV = 73 * MiB, WS_SB = 90 * MiB;
constexpr size_t WS_XB = 112 * MiB, WS_PROJ = 272 * MiB, WS_O = 672 * MiB, WS_ACT = 272 * MiB, WS_END = 832 * MiB;
static_assert(WS_WINA + (size_t)1536 * 1024 * 2 <= WS_WINB && WS_WINB + (size_t)2560 * 1024 * 2 <= WS_WMKV && WS_WMKV + (size_t)1024 * 1024 * 2 <= WS_WO && WS_WO + (size_t)2 * 1024 * 1024 * 2 <= WS_WGU &&
              WS_WGU + (size_t)2 * 5632 * 1024 * 2 <= WS_WD && WS_WD + (size_t)2 * 1024 * 2816 * 2 <= WS_SS && WS_SS + (size_t)MTOK * 16 <= WS_SSM && WS_SSM + (size_t)MMEM * 16 <= WS_MB &&
              WS_MB + (size_t)MMEM * 1024 * 2 <= WS_MKV && WS_MKV + (size_t)MMEM * 1024 * 2 <= WS_SB && WS_SB + (size_t)NTILE * 6 * FF * 4 <= WS_XB && WS_XB + (size_t)MTOK * 1024 * 2 <= WS_PROJ &&
              WS_PROJ + (size_t)MTOK * 2560 * 2 <= WS_O && WS_O + (size_t)MTOK * 1024 * 2 <= WS_END && WS_ACT + (size_t)MTOK * FF * 2 <= WS_END, "d_ws map");

static_assert((CW_PANEL + 64 * 320) * 4 <= (int)CTL_ZERO_BYTES && WS_SB + (size_t)NTILE * 6 * FF * 4 <= WS_XS && WS_XS + (size_t)320 * 4 * 256 * 4 <= WS_XB, "ctl / exchange map");
constexpr int LDS_X_OFF = 131072;
constexpr int MISC_OFF = 131072 + 2 * 17 * 128 * 4 + 512;
constexpr int LDS_BYTES = 131072 + 2 * 17 * 128 * 4 + 1024;
constexpr int NWAVES = 8;

__device__ __forceinline__ unsigned f2bf(float f) { unsigned u = __builtin_bit_cast(unsigned, f); return (u + 0x7fffu + ((u >> 16) & 1u)) >> 16; }
__device__ __forceinline__ unsigned pk2(float lo, float hi) { return f2bf(lo) | (f2bf(hi) << 16); }
__device__ __forceinline__ float wave_sum(float v) {
#pragma unroll
    for (int o = 1; o < 64; o <<= 1) v += __shfl_xor(v, o);
    return v;
}

#define XB_TMO      128
#define XB_XCNT(j)  (256  + 64 * (j))
#define XB_XSUB(j)  (1280 + 64 * (j))
#define XB_XGEN(j)  (2304 + 64 * (j))
#define XB_TOP      3328
#define XB_TOPGEN   3392
#define XCD_BAR_WORDS 3456
#define XB_SPIN_CAP (1u << 22)
__device__ __forceinline__ unsigned xb_ld(unsigned* p)              { return __hip_atomic_load(p, __ATOMIC_RELAXED, __HIP_MEMORY_SCOPE_AGENT); }
__device__ __forceinline__ unsigned xb_add(unsigned* p, unsigned v) { return __hip_atomic_fetch_add(p, v, __ATOMIC_RELAXED, __HIP_MEMORY_SCOPE_AGENT); }
__device__ __forceinline__ unsigned xb_xcc_id() { return (unsigned)__builtin_amdgcn_s_getreg((3 << 11) | 20) & 0xFu; }
#define XB_SPIN(cond, bar) do { unsigned _sp = 0; while (cond) { __builtin_amdgcn_s_sleep(1); \
    if ((++_sp & 255u) == 0u) { if (xb_ld(&(bar)[XB_TMO])) break; if (_sp > XB_SPIN_CAP) { atomicAdd(&(bar)[XB_TMO], 1u); break; } } } } while (0)
__device__ __forceinline__ void xcd_barrier_complete(unsigned* bar, unsigned x, unsigned& nloc, unsigned& nx) {
    const unsigned G = gridDim.x * gridDim.y * gridDim.z;
    unsigned sum, cnt, mine, sp = 0u;
    for (;;) {
        sum = 0u; cnt = 0u; mine = 0u;
#pragma unroll
        for (unsigned j = 0; j < 16; ++j) { const unsigned c = xb_ld(&bar[XB_XCNT(j)]); sum += c; cnt += (c > 0u) ? 1u : 0u; mine = (j == x) ? c : mine; }
        if (sum == G) break;
        __builtin_amdgcn_s_sleep(1);
        if ((++sp & 255u) == 0u) { if (xb_ld(&bar[XB_TMO])) break; if (sp > XB_SPIN_CAP) { atomicAdd(&bar[XB_TMO], 1u); break; } }
    }
    nloc = mine > 0u ? mine : 1u; nx = cnt > 0u ? cnt : 1u;
}
__device__ __forceinline__ void xcd_barrier(unsigned* bar, volatile __attribute__((address_space(3))) unsigned* st) {
    asm volatile("s_waitcnt vmcnt(0)" ::: "memory");
    __syncthreads();
    if (threadIdx.x == 0) {
        const unsigned x = xb_xcc_id();
        __builtin_amdgcn_s_waitcnt(0);
        unsigned nloc = st[0], nx = st[1];
        if (nloc == 0u) { xcd_barrier_complete(bar, x, nloc, nx); st[0] = nloc; st[1] = nx; }
        const unsigned old = xb_add(&bar[XB_XSUB(x)], 1u);
        const unsigned gen = old / nloc;
        if (old + 1u == (gen + 1u) * nloc) {
            __builtin_amdgcn_fence(__ATOMIC_RELEASE, "agent");
            asm volatile("s_waitcnt vmcnt(0)" ::: "memory");
            const unsigned og = xb_add(&bar[XB_TOP], 1u);
            const unsigned tg = og / nx;
            if (og + 1u == (tg + 1u) * nx) xb_add(&bar[XB_TOPGEN], 1u);
            else XB_SPIN(xb_ld(&bar[XB_TOPGEN]) == tg, bar);
            __builtin_amdgcn_fence(__ATOMIC_ACQUIRE, "agent");
            xb_add(&bar[XB_XGEN(x)], 1u);
            asm volatile("s_waitcnt vmcnt(0)" ::: "memory");
        } else {
            XB_SPIN(xb_ld(&bar[XB_XGEN(x)]) == gen, bar);
            __builtin_amdgcn_fence(__ATOMIC_ACQUIRE, "agent");
            asm volatile("s_waitcnt vmcnt(0)" ::: "memory");
        }
    }
    __syncthreads();
}

__device__ __forceinline__ void p0_transpose_item(const float* W, int K, int N, bf16* WT, int row_off, int mode, const float* gain, LAS float* scr, int item, int lane) {
    const int nblk = N / 32, kb = item / nblk, nb = item % nblk, k0 = 64 * kb, n0 = 32 * nb;
#pragma unroll 8
    for (int i = 0; i < 32; ++i) { const int kk = 2 * i + (lane >> 5); float v = W[(size_t)(k0 + kk) * N + n0 + (lane & 31)]; if (gain) v *= gain[k0 + kk]; scr[kk * 33 + (lane & 31)] = v; }
    asm volatile("s_waitcnt lgkmcnt(0)" ::: "memory");
    const int c = lane & 7;
    const int drow0 = (mode == 0) ? row_off + n0 : (n0 / 128) * 256 + ((n0 % 128) / 32) * 64 + (mode - 1) * 32;
#pragma unroll
    for (int j = 0; j < 4; ++j) { const int n = (lane >> 3) + 8 * j; const LAS float* s = scr + (8 * c) * 33 + n;
        u32x4 o; o.x = pk2(s[0 * 33], s[1 * 33]); o.y = pk2(s[2 * 33], s[3 * 33]); o.z = pk2(s[4 * 33], s[5 * 33]); o.w = pk2(s[6 * 33], s[7 * 33]);
        *(u32x4*)(WT + (size_t)(drow0 + n) * K + k0 + 8 * c) = o; }
    asm volatile("s_waitcnt lgkmcnt(0)" ::: "memory");
}
__device__ __forceinline__ void row_to_bf16(const float* xrow, bf16* orow, float* ssrow, int lane) {
    const f32x4* xr = (const f32x4*)xrow + lane;
    f32x4 v[4]; float s = 0.f;
#pragma unroll
    for (int j = 0; j < 4; ++j) { v[j] = xr[64 * j]; s += (v[j].x * v[j].x + v[j].y * v[j].y) + (v[j].z * v[j].z + v[j].w * v[j].w); }
    s = wave_sum(s);
    u32x2* o8 = (u32x2*)orow + lane;
#pragma unroll
    for (int j = 0; j < 4; ++j) { u32x2 w; w.x = pk2(v[j].x, v[j].y); w.y = pk2(v[j].z, v[j].w); o8[64 * j] = w; }
    if (lane == 0) *(f32x4*)ssrow = (f32x4){s, 0.f, 0.f, 0.f};
}

struct Args {
    const float* in[19]; float* out; unsigned char* ws; int ph_lo, ph_hi;
};

constexpr float LOG2E = 1.4426950408889634f;
constexpr float CSC = 0.125f * LOG2E;
#define MFMA32(a, b, c) __builtin_amdgcn_mfma_f32_32x32x16_bf16((a), (b), (c), 0, 0, 0)
__device__ __forceinline__ int crow(int i, int hi) { return (i & 3) + 8 * (i >> 2) + 4 * hi; }

template <int UN> struct VRegs { u32x4 a[UN], b[UN]; };
template <int UN> __device__ __forceinline__ void vt_load(VRegs<UN>& R, const bf16* Vbase, int pitch, int gk0, int kl_lo, int kl_hi) {
    const int npair = (kl_hi - kl_lo) >> 1, total = npair * 8;
    const unsigned rcp = (1u << 24) / (unsigned)npair + 1u;
#pragma unroll
    for (int uu = 0; uu < UN; ++uu) {
        const int idx = threadIdx.x + uu * NWAVES * 64;
        if (idx < total) {
            const int c = (int)(((unsigned)idx * rcp) >> 24), p = idx - c * npair, kl = kl_lo + 2 * p;
            const bf16* src = Vbase + (size_t)(gk0 + kl) * pitch + 8 * c;
            R.a[uu] = *(const u32x4*)src; R.b[uu] = *(const u32x4*)(src + pitch);
        }
    }
}
template <int UN> __device__ __forceinline__ void vt_store(const VRegs<UN>& R, LAS unsigned char* vt, int VS, int kl_lo, int kl_hi) {
    const int npair = (kl_hi - kl_lo) >> 1, total = npair * 8, rs = VS / 2;
    const unsigned rcp = (1u << 24) / (unsigned)npair + 1u;
#pragma unroll
    for (int uu = 0; uu < UN; ++uu) {
        const int idx = threadIdx.x + uu * NWAVES * 64;
        if (idx < total) {
            const int c = (int)(((unsigned)idx * rcp) >> 24), p = idx - c * npair, kl = kl_lo + 2 * p;
            LAS unsigned* dst = (LAS unsigned*)(vt + ((size_t)(8 * c) * VS + kl) * 2);
#pragma unroll
            for (int i = 0; i < 4; ++i) {
                dst[(2 * i) * rs] = (R.a[uu][i] & 0xffffu) | (R.b[uu][i] << 16);
                dst[(2 * i + 1) * rs] = (R.a[uu][i] >> 16) | (R.b[uu][i] & 0xffff0000u);
            }
        }
    }
}
template <int UN> struct KRegs { u32x4 a[UN]; };
template <int UN> __device__ __forceinline__ void kt_load(KRegs<UN>& R, const bf16* Kbase, int pitch, int gk0, int kl_lo, int kl_hi) {
    const int total = (kl_hi - kl_lo) * 8;
#pragma unroll
    for (int uu = 0; uu < UN; ++uu) {
        const int idx = threadIdx.x + uu * NWAVES * 64;
        if (idx < total) { const int kl = kl_lo + (idx >> 3), c = idx & 7; R.a[uu] = *(const u32x4*)(Kbase + (size_t)(gk0 + kl) * pitch + 8 * c); }
    }
}
template <int UN> __device__ __forceinline__ void kt_store(const KRegs<UN>& R, LAS unsigned char* kt, int kl_lo, int kl_hi) {
    const int total = (kl_hi - kl_lo) * 8;
#pragma unroll
    for (int uu = 0; uu < UN; ++uu) {
        const int idx = threadIdx.x + uu * NWAVES * 64;
        if (idx < total) { const int kl = kl_lo + (idx >> 3), c = idx & 7; *(LAS u32x4*)(kt + kl * 128 + ((c ^ ((kl >> 1) & 7)) << 4)) = R.a[uu]; }
    }
}
__device__ __forceinline__ void load_kfrag_lds(bf16x8 (&f)[4], const LAS unsigned char* kt, int kl  , int hi) {
    const LAS unsigned char* p = kt + kl * 128; const int sw = (kl >> 1) & 7;
#pragma unroll
    for (int ks = 0; ks < 4; ++ks) f[ks] = *(const LAS bf16x8*)(p + (((2 * ks + hi) ^ sw) << 4));
}
__device__ __forceinline__ void load_frag4(bf16x8 (&f)[4], const bf16* p) {
#pragma unroll
    for (int ks = 0; ks < 4; ++ks) f[ks] = *(const bf16x8*)(p + 16 * ks);
}
template <bool RAW = false>
__device__ __forceinline__ void attn_step(f32x16& s, float& m, float& l, f32x16 (&o)[2], const LAS unsigned char* vt, int VSb, int kb0, int lane) {
    float mxa = fmaxf(fmaxf(s[0], s[1]), s[2]), mxb = fmaxf(fmaxf(s[3], s[4]), s[5]);
    mxa = fmaxf(fmaxf(mxa, s[6]), s[7]); mxb = fmaxf(fmaxf(mxb, s[8]), s[9]); mxa = fmaxf(fmaxf(mxa, s[10]), s[11]); mxb = fmaxf(fmaxf(mxb, s[12]), s[13]); mxa = fmaxf(fmaxf(mxa, s[14]), s[15]);
    float mx = fmaxf(mxa, mxb);
    if constexpr (RAW) mx *= CSC;
    mx = fmaxf(mx, __shfl_xor(mx, 32));
    if (__any(mx > m + 8.0f)) {
        const float mn = fmaxf(m, mx);
        const float corr = __builtin_amdgcn_exp2f(m - mn);
        m = mn; l = l * corr;
#pragma unroll
        for (int d = 0; d < 2; ++d) o[d] = o[d] * corr;
    }
    float sum = 0.f;
#pragma unroll
    for (int i = 0; i < 16; ++i) { s[i] = __builtin_amdgcn_exp2f(RAW ? fmaf(s[i], CSC, -m) : s[i] - m); sum += s[i]; }
    sum += __shfl_xor(sum, 32);
    l = l + sum;
    bf16x8 pb[2];
#pragma unroll
    for (int st = 0; st < 2; ++st) {
        u32x4 w; w.x = pg8::cvt_pk_bf16(s[8 * st + 0], s[8 * st + 1]); w.y = pg8::cvt_pk_bf16(s[8 * st + 2], s[8 * st + 3]); w.z = pg8::cvt_pk_bf16(s[8 * st + 4], s[8 * st + 5]); w.w = pg8::cvt_pk_bf16(s[8 * st + 6], s[8 * st + 7]);
        pb[st] = __builtin_bit_cast(bf16x8, w);
    }
    const int dl = lane & 31, hi = lane >> 5;
#pragma unroll
    for (int db = 0; db < 2; ++db)
#pragma unroll
        for (int st = 0; st < 2; ++st) {
            const LAS unsigned char* p = vt + (size_t)(32 * db + dl) * VSb + (size_t)(kb0 + 16 * st + 4 * hi) * 2;
            const s16x4 a0 = *(const LAS s16x4*)p, a1 = *(const LAS s16x4*)(p + 16);
            const bf16x8 a = __builtin_shufflevector(a0, a1, 0, 1, 2, 3, 4, 5, 6, 7);
            o[db] = MFMA32(a, pb[st], o[db]);
        }
}
__device__ __forceinline__ void store_o(const f32x16 (&o)[2], float l, bf16* orow, int hi) {
    const float inv = 1.0f / l;
#pragma unroll
    for (int db = 0; db < 2; ++db)
#pragma unroll
        for (int ig = 0; ig < 4; ++ig) {
            u32x2 w; w.x = pg8::cvt_pk_bf16(o[db][4 * ig] * inv, o[db][4 * ig + 1] * inv); w.y = pg8::cvt_pk_bf16(o[db][4 * ig + 2] * inv, o[db][4 * ig + 3] * inv);
            *(u32x2*)(orow + 32 * db + 8 * ig + 4 * hi) = w;
        }
}
__device__ __forceinline__ void tile_seq(int pm, int& seq, int& jb, int& T, int& seqbase) {
    if (pm < 256) { seq = pm >> 3; jb = pm & 7; T = 2048; seqbase = seq * 2048; } else { seq = 32; jb = pm - 256; T = 16384; seqbase = MPROMPT; }
}

__device__ __forceinline__ void window_chunk(const LAS unsigned char* vt, int VSb, const LAS unsigned char* kt, const bf16x8 (&qf)[4], bf16* O, int seqbase, int T, int jb, int g, int r, int qc, float sink, int lane) {
    const int q = lane & 31, hi = lane >> 5, hq = 3 * g + r, t0 = 256 * jb + 32 * qc, t = t0 + q;
    const float slope2 = exp2f(-8.0f * (float)(hq + 1) / 12.0f) * LOG2E;
    float m = sink * LOG2E, l = 1.0f;
    f32x16 o[2];
#pragma unroll
    for (int i = 0; i < 16; ++i) { o[0][i] = 0.f; o[1][i] = 0.f; }
    const int kb_lo = (t0 / 32 - 4) > 0 ? (t0 / 32 - 4) : 0, kb_hi = (t0 / 32 + 4) < (T / 32 - 1) ? (t0 / 32 + 4) : (T / 32 - 1);
    for (int kb = kb_lo; kb <= kb_hi; ++kb) {
        const int kbl = 32 * kb - 256 * jb + 128;
        bf16x8 kf[4]; load_kfrag_lds(kf, kt, kbl + q, hi);
        f32x16 s;
#pragma unroll
        for (int i = 0; i < 16; ++i) s[i] = 0.f;
#pragma unroll
        for (int ks = 0; ks < 4; ++ks) s = MFMA32(kf[ks], qf[ks], s);
        const float base = (float)(t - 32 * kb - 4 * hi);
        if (kb != t0 / 32) {
            const float ks = (kb < t0 / 32) ? slope2 : -slope2, A = -ks * base;
#pragma unroll
            for (int i = 0; i < 16; ++i) s[i] = fmaf(s[i], CSC, fmaf((float)((i & 3) + 8 * (i >> 2)), ks, A));
        } else {
#pragma unroll
            for (int i = 0; i < 16; ++i) { const float d = base - (float)((i & 3) + 8 * (i >> 2)); s[i] = fmaf(s[i], CSC, -slope2 * fabsf(d)); }
        }
        if (kb == t0 / 32 - 4 || kb == t0 / 32 + 4) {
#pragma unroll
            for (int i = 0; i < 16; ++i) { const float d = base - (float)((i & 3) + 8 * (i >> 2)); if (fabsf(d) > 128.0f) s[i] = -INFINITY; }
        }
        attn_step(s, m, l, o, vt, VSb, kbl, lane);
    }
    store_o(o, l, O + (size_t)(seqbase + t) * 1024 + hq * 64, hi);
}
__device__ __forceinline__ void mem_chunk(const LAS unsigned char* vt, int VSb, const LAS unsigned char* kt, const bf16x8 (&qf)[4], bf16* obase, int row0, int lane) {
    const int q = lane & 31, hi = lane >> 5;
    float m = -1e30f, l = 0.f;
    f32x16 o[2];
#pragma unroll
    for (int i = 0; i < 16; ++i) { o[0][i] = 0.f; o[1][i] = 0.f; }
    for (int kb = 0; kb < 8; ++kb) {
        bf16x8 kf[4]; load_kfrag_lds(kf, kt, 32 * kb + q, hi);
        f32x16 s;
#pragma unroll
        for (int i = 0; i < 16; ++i) s[i] = 0.f;
#pragma unroll
        for (int ks = 0; ks < 4; ++ks) s = MFMA32(kf[ks], qf[ks], s);
        attn_step<true>(s, m, l, o, vt, VSb, 32 * kb, lane);
    }
    store_o(o, l, obase + (size_t)(row0 + q) * 1024, hi);
}
__device__ __forceinline__ void na_chunk(const LAS unsigned char* vt, int VSb, const LAS float* rpbL, const bf16* kptr  , bf16* optr  ,
                                         const bf16x8 (&qf)[4], bf16x8 (&kf)[4], bf16x8 (&kf1)[4], int row_q, int c, int col0, int r0q, int kr_lo, int kr_hi, int klo, int lane) {
    const int hi = lane >> 5;
    int c0 = c - 8; c0 = c0 < 0 ? 0 : c0; c0 = c0 > 48 ? 48 : c0;
    float m = -1e30f, l = 0.f;
    f32x16 o[2];
#pragma unroll
    for (int i = 0; i < 16; ++i) { o[0][i] = 0.f; o[1][i] = 0.f; }
    int dcc[16];
#pragma unroll
    for (int ii = 0; ii < 16; ++ii) { const int kc = col0 + crow(ii, hi); dcc[ii] = ((unsigned)(kc - c0) < 16u) ? (kc - c + 15) : 31; }
    bf16x8 kn[4];
#define NA_BLOCK(KF) do { \
        f32x16 s; \
        _Pragma("unroll") for (int ii = 0; ii < 16; ++ii) s[ii] = 0.f; \
        _Pragma("unroll") for (int ks = 0; ks < 4; ++ks) s = MFMA32(KF[ks], qf[ks], s); \
        const int br = ((unsigned)(kr - r0q) < 8u) ? (kr - row_q + 7) : 15;     \
        const LAS float* brow = rpbL + br * 32; \
        _Pragma("unroll") for (int ii = 0; ii < 16; ++ii) s[ii] = fmaf(s[ii], CSC, brow[dcc[ii]]); \
        attn_step(s, m, l, o, vt, VSb, (kr - klo) * 64 + col0, lane); } while (0)
#define NA_LOAD(KF) do { if (kr + 2 <= kr_hi) load_frag4(KF, kptr + (size_t)(kr + 2 - kr_lo) * 64 * 2560); } while (0)
    for (int kr = kr_lo;;) {
        NA_LOAD(kn);  NA_BLOCK(kf);  if (++kr > kr_hi) break;
        NA_LOAD(kf);  NA_BLOCK(kf1); if (++kr > kr_hi) break;
        NA_LOAD(kf1); NA_BLOCK(kn);  if (++kr > kr_hi) break;
    }
#undef NA_BLOCK
#undef NA_LOAD
    store_o(o, l, optr, hi);
}

#define LDS_BARRIER() do { asm volatile("s_waitcnt lgkmcnt(0)" ::: "memory"); __builtin_amdgcn_s_barrier(); asm volatile("" ::: "memory"); } while (0)
constexpr int MEM_KT_OFF = 34816;
__device__ __forceinline__ void mem_units(LAS unsigned char* lds, const bf16* proj, int qpitch, int qcol, const bf16* mkv, int layer, bf16* O, int wave, int lane, int vcu) {
    const int N = NTILE * 4, G = gridDim.x;
    VRegs<2> VR; KRegs<4> KR; bf16x8 qn[4];
    const int ql = (lane & 31), qh = 8 * (lane >> 5);
    if (vcu < N) { const int hm = vcu / NTILE, pm = vcu - hm * NTILE; int seq, jb, T, seqbase; tile_seq(pm, seq, jb, T, seqbase);
        vt_load<2>(VR, mkv + layer * 512 + 256 + hm * 64, 1024, seq * 256, 0, 256); kt_load<4>(KR, mkv + layer * 512 + hm * 64, 1024, seq * 256, 0, 256);
        load_frag4(qn, proj + qcol + hm * 64 + (size_t)(pm * 256 + 32 * wave + ql) * qpitch + qh); }
    for (int u = vcu; u < N; u += G) {
        const int hm = u / NTILE, pm = u - hm * NTILE; int seq, jb, T, seqbase; tile_seq(pm, seq, jb, T, seqbase);
        bf16x8 qf[4];
#pragma unroll
        for (int ks = 0; ks < 4; ++ks) qf[ks] = qn[ks];
        LDS_BARRIER();
        vt_store<2>(VR, lds, 260, 0, 256); kt_store<4>(KR, lds + MEM_KT_OFF, 0, 256);
        LDS_BARRIER();
        const int un = u + G;
        if (un < N) { const int hm2 = un / NTILE, pm2 = un - hm2 * NTILE; int seq2, jb2, T2, sb2; tile_seq(pm2, seq2, jb2, T2, sb2);
            vt_load<2>(VR, mkv + layer * 512 + 256 + hm2 * 64, 1024, seq2 * 256, 0, 256); kt_load<4>(KR, mkv + layer * 512 + hm2 * 64, 1024, seq2 * 256, 0, 256);
            load_frag4(qn, proj + qcol + hm2 * 64 + (size_t)(pm2 * 256 + 32 * wave + ql) * qpitch + qh); }
        mem_chunk(lds, 260 * 2, lds + MEM_KT_OFF, qf, O + 768 + hm * 64, pm * 256 + 32 * wave, lane);
    }
}

#define LOAD_ARGS() \
    const CAS Args* ap_ = (const CAS Args*)__builtin_amdgcn_kernarg_segment_ptr(); asm volatile("" : "+s"(ap_)); \
    unsigned char* ws = ap_->ws; float* out = ap_->out; (void)out; \
    bf16* WinA = (bf16*)(ws + WS_WINA); bf16* WinB = (bf16*)(ws + WS_WINB); bf16* Wmkv = (bf16*)(ws + WS_WMKV); bf16* Wo = (bf16*)(ws + WS_WO); bf16* Wgu = (bf16*)(ws + WS_WGU); bf16* Wd = (bf16*)(ws + WS_WD); \
    float* SS = (float*)(ws + WS_SS); float* SSM = (float*)(ws + WS_SSM); bf16* MB = (bf16*)(ws + WS_MB); bf16* MKV = (bf16*)(ws + WS_MKV); float* SB = (float*)(ws + WS_SB); \
    bf16* XB = (bf16*)(ws + WS_XB); bf16* PROJ = (bf16*)(ws + WS_PROJ); bf16* OB = (bf16*)(ws + WS_O); bf16* ACT = (bf16*)(ws + WS_ACT); \
    (void)WinA; (void)WinB; (void)Wmkv; (void)Wo; (void)Wgu; (void)Wd; (void)SS; (void)SSM; (void)MB; (void)MKV; (void)SB; (void)XB; (void)PROJ; (void)OB; (void)ACT;
#define ARG(k) (ap_->in[k])
template <int layer>
__device__ __forceinline__ void layer_phases(LAS unsigned char* lds, LAS float* ldsx, const int lo, const int hi_ph, const int G, const int bx) {
    int tid = threadIdx.x; asm volatile("" : "+v"(tid));
    const int lane = tid & 63, wave = __builtin_amdgcn_readfirstlane(tid >> 6);
#define IN(k) (lo <= (k) && (k) < hi_ph)
#define SEAM(k) do { if (IN(k) && IN((k) + 1)) { if ((k) == 0) cg::this_grid().sync(); else { const CAS Args* apb_ = (const CAS Args*)__builtin_amdgcn_kernarg_segment_ptr(); asm volatile("" : "+s"(apb_)); xcd_barrier((unsigned*)(apb_->ws + WS_CTL), (volatile LAS unsigned*)(lds + MISC_OFF)); } } } while (0)
        const int pb = 1 + 6 * layer;
        const int NP = layer == 0 ? 1536 : 2560;
        if (IN(pb)) {
            LOAD_ARGS();
            for (int rep = 0; rep < NREP(1); ++rep)
            { pg8::Gemm g{XB, layer == 0 ? WinA : WinB, MTOK, NP, D, 0}; pg8::StaticOrder S; S.init(MTOK, NP, G, bx);
              pg8::EpiScaleBf16 E{PROJ, NP, SS};
              pg8::gemm_phase<pg8::EpiScaleBf16, pg8::StaticOrder>(lds, g, S, E); }
            { pg8::Gemm g{MB, Wmkv + (size_t)layer * 512 * 1024, MMEM, 512, D, 0}; pg8::StaticOrder S; S.init(MMEM, 512, G, (bx + G / 2) % G);
              pg8::EpiScaleBf16 E{MKV + layer * 512, 1024, SSM};
              pg8::gemm_phase<pg8::EpiScaleBf16, pg8::StaticOrder>(lds, g, S, E); }
        }
        SEAM(pb);
        if (IN(pb + 1)) {
            LOAD_ARGS();
            const float* sink_a = ARG(7); const float* rpb_b = ARG(9);
            const int vcu = (G % 8 == 0) ? (bx % 8) * (G / 8) + bx / 8 : bx;
            if (layer == 0) {
                {
                    const int N = NTILE * 4;
                    VRegs<4> VR; KRegs<8> KR; bf16x8 qn[4]; LAS unsigned char* ktw = lds + 69632;
                    if (vcu < N) { const int g = vcu / NTILE, pm = vcu - g * NTILE; int seq, jb, T, seqbase; tile_seq(pm, seq, jb, T, seqbase);
                        const int kl_lo = (jb == 0) ? 128 : 0; int kl_hi = T - 256 * jb + 128; kl_hi = kl_hi > 512 ? 512 : kl_hi;
                        vt_load<4>(VR, PROJ + 1024 + g * 64, 1536, seqbase + 256 * jb - 128, kl_lo, kl_hi); kt_load<8>(KR, PROJ + 768 + g * 64, 1536, seqbase + 256 * jb - 128, kl_lo, kl_hi);
                        { const int c0_ = 3 * wave, r0_ = c0_ >> 3, qc0_ = c0_ & 7; load_frag4(qn, PROJ + (size_t)(seqbase + 256 * jb + 32 * qc0_ + (lane & 31)) * 1536 + (3 * g + r0_) * 64 + 8 * (lane >> 5)); } }
                    for (int u = vcu; u < N; u += G) {
                        const int g = u / NTILE, pm = u - g * NTILE; int seq, jb, T, seqbase; tile_seq(pm, seq, jb, T, seqbase);
                        const int kl_lo = (jb == 0) ? 128 : 0; int kl_hi = T - 256 * jb + 128; kl_hi = kl_hi > 512 ? 512 : kl_hi;
                        LDS_BARRIER();
                        vt_store<4>(VR, lds, 516, kl_lo, kl_hi); kt_store<8>(KR, ktw, kl_lo, kl_hi);
                        LDS_BARRIER();
                        const int un = u + G;
                        if (un < N) { const int g2 = un / NTILE, pm2 = un - g2 * NTILE; int seq2, jb2, T2, sb2; tile_seq(pm2, seq2, jb2, T2, sb2);
                            const int kl_lo2 = (jb2 == 0) ? 128 : 0; int kl_hi2 = T2 - 256 * jb2 + 128; kl_hi2 = kl_hi2 > 512 ? 512 : kl_hi2;
                            vt_load<4>(VR, PROJ + 1024 + g2 * 64, 1536, sb2 + 256 * jb2 - 128, kl_lo2, kl_hi2); kt_load<8>(KR, PROJ + 768 + g2 * 64, 1536, sb2 + 256 * jb2 - 128, kl_lo2, kl_hi2); }
#pragma unroll 1
                        for (int i = 0; i < 3; ++i) { const int cidx = 3 * wave + i, r = cidx >> 3, qc = cidx & 7;
                            bf16x8 qf[4];
#pragma unroll
                            for (int ks = 0; ks < 4; ++ks) qf[ks] = qn[ks];
                            {
                                int u2 = u, i2 = i + 1; if (i2 == 3) { i2 = 0; u2 = u + G; }
                                if (u2 < N) { const int g2 = u2 / NTILE, pm2 = u2 - g2 * NTILE; int seq2, jb2, T2, sb2; tile_seq(pm2, seq2, jb2, T2, sb2);
                                    const int c2 = 3 * wave + i2, r2 = c2 >> 3, qc2 = c2 & 7;
                                    load_frag4(qn, PROJ + (size_t)(sb2 + 256 * jb2 + 32 * qc2 + (lane & 31)) * 1536 + (3 * g2 + r2) * 64 + 8 * (lane >> 5)); }
                            }
                            window_chunk(lds, 516 * 2, ktw, qf, OB, seqbase, T, jb, g, r, qc, sink_a[3 * g + r], lane); }
                    }
                }
                mem_units(lds, PROJ, 1536, 1280, MKV, 0, OB, wave, lane, vcu);
            } else {
                LAS float* rpbL = (LAS float*)(lds + 98304);
                {
                    const int N = NTILE * 12;
                    VRegs<6> VR; float rpbv = 0.f; bf16x8 qn[4], kn0[4];
#define NA_QK(uu_) { NA_DESC(uu_, hq_, jbq_, sbq_, rowsq_, kloq_, khiq_); (void)kloq_; (void)khiq_; const int rpq_ = wave >> 2, aq_ = wave & 3, qq_ = lane & 31, hiq_ = lane >> 5; \
                        const int rAq_ = 4 * jbq_ + 2 * rpq_, rowq_ = rAq_ + (qq_ >> 4), cq_ = 16 * aq_ + (qq_ & 15); int col0q_ = 16 * aq_ - 8; col0q_ = col0q_ < 0 ? 0 : col0q_; col0q_ = col0q_ > 32 ? 32 : col0q_; \
                        int krq_ = rAq_ - 4; krq_ = krq_ < 0 ? 0 : krq_; krq_ = krq_ > rowsq_ - 8 ? rowsq_ - 8 : krq_; \
                        const bf16* kpq_ = PROJ + 768 + hq_ * 64 + 8 * hiq_ + (size_t)(sbq_ + krq_ * 64 + col0q_ + qq_) * 2560; \
                        load_frag4(qn, PROJ + (size_t)(sbq_ + rowq_ * 64 + cq_) * 2560 + hq_ * 64 + 8 * hiq_); load_frag4(kn0, kpq_); }
#define NA_DESC(uu_, h_, jb_, sb_, rows_, klo_, khi_) const int h_ = (uu_) / NTILE; int jb_, sb_, rows_, klo_, khi_; { const int pm_ = (uu_) - h_ * NTILE; int seq_, T_; tile_seq(pm_, seq_, jb_, T_, sb_); rows_ = T_ / 64; \
                        klo_ = 4 * jb_ - 4; klo_ = klo_ < 0 ? 0 : klo_; klo_ = klo_ > rows_ - 8 ? rows_ - 8 : klo_; khi_ = 4 * jb_ + 3 - 4; khi_ = khi_ < 0 ? 0 : khi_; khi_ = khi_ > rows_ - 8 ? rows_ - 8 : khi_; khi_ += 8; }
                    if (vcu < N) { NA_DESC(vcu, h0, jb0, sb0, rows0, klo0, khi0);
                        vt_load<6>(VR, PROJ + 1536 + h0 * 64, 2560, sb0 + klo0 * 64, 0, (khi0 - klo0) * 64); { const int tr = tid >> 5, tc = tid & 31; rpbv = (tr < 15 && tc < 31) ? rpb_b[h0 * 465 + tr * 31 + tc] * LOG2E : -INFINITY; } NA_QK(vcu); }
                    for (int u = vcu; u < N; u += G) {
                        NA_DESC(u, h, jb, seqbase, rows, klo, khi);
                        const int rp = wave >> 2, a = wave & 3, q = lane & 31, hi = lane >> 5;
                        const int rA = 4 * jb + 2 * rp, row_q = rA + (q >> 4), c = 16 * a + (q & 15);
                        int col0 = 16 * a - 8; col0 = col0 < 0 ? 0 : col0; col0 = col0 > 32 ? 32 : col0;
                        int r0q = row_q - 4; r0q = r0q < 0 ? 0 : r0q; r0q = r0q > rows - 8 ? rows - 8 : r0q;
                        int kr_lo = rA - 4; kr_lo = kr_lo < 0 ? 0 : kr_lo; kr_lo = kr_lo > rows - 8 ? rows - 8 : kr_lo;
                        int kr_hi = rA + 1 - 4; kr_hi = kr_hi < 0 ? 0 : kr_hi; kr_hi = kr_hi > rows - 8 ? rows - 8 : kr_hi; kr_hi += 7;
                        const bf16* kptr = PROJ + 768 + h * 64 + 8 * hi + (size_t)(seqbase + kr_lo * 64 + col0 + q) * 2560;
                        bf16x8 qf[4], kf[4], kf1[4];
#pragma unroll
                        for (int ks = 0; ks < 4; ++ks) { qf[ks] = qn[ks]; kf[ks] = kn0[ks]; }
                        load_frag4(kf1, kptr + (size_t)64 * 2560);
                        LDS_BARRIER();
                        vt_store<6>(VR, lds, 708, 0, (khi - klo) * 64);
                        rpbL[tid] = rpbv;
                        LDS_BARRIER();
                        const int un = u + G;
                        if (un < N) { NA_DESC(un, h2, jb2, sb2, rows2, klo2, khi2);
                            vt_load<6>(VR, PROJ + 1536 + h2 * 64, 2560, sb2 + klo2 * 64, 0, (khi2 - klo2) * 64); { const int tr = tid >> 5, tc = tid & 31; rpbv = (tr < 15 && tc < 31) ? rpb_b[h2 * 465 + tr * 31 + tc] * LOG2E : -INFINITY; } NA_QK(un); }
                        na_chunk(lds, 708 * 2, rpbL, kptr, OB + (size_t)(seqbase + row_q * 64 + c) * 1024 + h * 64, qf, kf, kf1, row_q, c, col0, r0q, kr_lo, kr_hi, klo, lane);
                    }
#undef NA_QK
#undef NA_DESC
                }
                mem_units(lds, PROJ, 2560, 2304, MKV, 1, OB, wave, lane, vcu);
            }
        }
        SEAM(pb + 1);
        if (IN(pb + 2)) {
            LOAD_ARGS();
            pg8::Gemm g{OB, Wo + (size_t)layer * 1024 * 1024, MTOK, D, D, 0}; pg8::StaticOrder S; S.init(MTOK, D, G, bx);
            pg8::EpiResid E{XB, SS, ldsx};
            pg8::gemm_phase<pg8::EpiResid, pg8::StaticOrder>(lds, g, S, E);
        }
        SEAM(pb + 2);
        if (IN(pb + 3)) {
            LOAD_ARGS();
            const float* conv_w = ARG(15); const float* conv_b = ARG(16);
            pg8::Gemm g{XB, Wgu + (size_t)layer * 5632 * 1024, MTOK, 5632, D, 0}; pg8::StaticOrder S; S.init(MTOK, 5632, G, bx);
            pg8::EpiGateUp E{ACT, SS, conv_w + (size_t)layer * 3 * FF, conv_b + (size_t)layer * FF, SB, ldsx};
            if (tid < 128) { ldsx[tid] = 0.f; ldsx[(17 + 16) * 128 + tid] = 0.f; }
            __syncthreads();
            for (int rep = 0; rep < NREP(6); ++rep) pg8::gemm_phase<pg8::EpiGateUp, pg8::StaticOrder>(lds, g, S, E);
        }
        SEAM(pb + 3);
        if (IN(pb + 4)) {
            LOAD_ARGS();
            const float* conv_w = ARG(15);
            const float* cw = conv_w + (size_t)layer * 3 * FF;
            for (int idx = bx * (NWAVES * 64) + tid; idx < NTILE * 2 * FF; idx += G * NWAVES * 64) {
                const int col = idx % FF, pw = idx / FF, pm = pw >> 1, which = pw & 1;
                const float part = SB[(size_t)(pw * 3 + 1) * FF + col], uu = SB[(size_t)(pw * 3 + 2) * FF + col];
                const bool seq_start = (pm < 256) ? ((pm & 7) == 0) : (pm == 256);
                const bool seq_end = (pm < 256) ? ((pm & 7) == 7) : (pm == NTILE - 1);
                float c = part;
                if (which == 0) { if (!seq_start) c += cw[col] * SB[(size_t)(((pm - 1) * 2 + 1) * 3) * FF + col]; }
                else { if (!seq_end) c += cw[2 * FF + col] * SB[(size_t)(((pm + 1) * 2) * 3) * FF + col]; }
                const float sg = 1.0f / (1.0f + __builtin_amdgcn_exp2f(-LOG2E * c));
                ACT[pg8::ilv_off(pm * 256 + (which ? 255 : 0), col, FF)] = (bf16)f2bf(c * sg * uu);
            }
        }
        SEAM(pb + 4);
        if (IN(pb + 5)) {
            LOAD_ARGS();
            pg8::Gemm g{ACT, Wd + (size_t)layer * 1024 * FF, MTOK, D, FF, 1}; pg8::StaticOrder S; S.init(MTOK, D, G, bx);
            if constexpr (layer == 0) {
                pg8::EpiResid E{XB, SS, ldsx};
                pg8::gemm_phase<pg8::EpiResid, pg8::StaticOrder>(lds, g, S, E);
            } else {
                pg8::EpiFinal E{XB, out, ARG(18), (float*)(ws + WS_XS), (unsigned*)(ws + WS_CTL) + CW_PANEL, ldsx};
                pg8::gemm_phase<pg8::EpiFinal, pg8::StaticOrder>(lds, g, S, E);
            }
        }
        if constexpr (layer == 0) { SEAM(pb + 5); }
#undef IN
#undef SEAM
}

__global__ void __launch_bounds__(NWAVES * 64, 2) mega_fwd(Args args) {
    extern __shared__ __attribute__((aligned(16))) unsigned char lds_raw[];
    LAS unsigned char* lds = (LAS unsigned char*)lds_raw;
    const int G = gridDim.x, bx = blockIdx.x;
    if (threadIdx.x < 16) ((volatile LAS unsigned*)(lds + MISC_OFF))[threadIdx.x] = 0u;
    __syncthreads();
    { const CAS Args* apc_ = (const CAS Args*)__builtin_amdgcn_kernarg_segment_ptr(); if (apc_->ph_hi - apc_->ph_lo > 1 && threadIdx.x == 0) (void)xb_add((unsigned*)(apc_->ws + WS_CTL) + XB_XCNT(xb_xcc_id()), 1u); }
#define PHASE_TID() int tid = threadIdx.x; asm volatile("" : "+v"(tid)); const int lane = tid & 63, wave = __builtin_amdgcn_readfirstlane(tid >> 6); (void)lane; (void)wave;
    LAS float* ldsx = (LAS float*)(lds + LDS_X_OFF);

    int lo, hi_ph; { const CAS Args* ap0 = (const CAS Args*)__builtin_amdgcn_kernarg_segment_ptr(); lo = ap0->ph_lo; hi_ph = ap0->ph_hi; }
#define IN(k) (lo <= (k) && (k) < hi_ph)
#define SEAM(k) do { if (IN(k) && IN((k) + 1)) { if ((k) == 0) cg::this_grid().sync(); else { const CAS Args* apb_ = (const CAS Args*)__builtin_amdgcn_kernarg_segment_ptr(); asm volatile("" : "+s"(apb_)); xcd_barrier((unsigned*)(apb_->ws + WS_CTL), (volatile LAS unsigned*)(lds + MISC_OFF)); } } } while (0)

    if (IN(0)) {
        LOAD_ARGS(); PHASE_TID();
        const float* x_prompt = ARG(0); const float* x_sample = ARG(1); const float* mem_prompt = ARG(2); const float* mem_sample = ARG(3); const float* g_mix = ARG(4); const float* g_mem = ARG(5);
        const float* w_in_a = ARG(6); const float* w_in_b = ARG(8); const float* w_mem_kv = ARG(10); const float* w_o = ARG(11); const float* g_ffn = ARG(12); const float* w_gate = ARG(13); const float* w_up = ARG(14); const float* w_down = ARG(17);
        LAS float* scr = (LAS float*)(lds + wave * 16384);
        const int gw = bx * NWAVES + wave, NGW = G * NWAVES;
        constexpr int I_INA = 16 * 48, I_INB = 16 * 80, I_MKV = 16 * 16, I_O = 16 * 32, I_G = 16 * 88, I_D = 44 * 32;
        constexpr int NITEMS = I_INA + I_INB + 2 * I_MKV + 2 * I_O + 4 * I_G + 2 * I_D;
        for (int rep = 0; rep < NREP(0); ++rep) {
        for (int it = gw; it < NITEMS; it += NGW) {
            int r = it;
            if (r < I_INA) { p0_transpose_item(w_in_a, 1024, 1536, WinA, 0, 0, g_mix, scr, r, lane); continue; } r -= I_INA;
            if (r < I_INB) { p0_transpose_item(w_in_b, 1024, 2560, WinB, 0, 0, g_mix + 1024, scr, r, lane); continue; } r -= I_INB;
            if (r < 2 * I_MKV) { const int li = r / I_MKV; p0_transpose_item(w_mem_kv + (size_t)li * 1024 * 512, 1024, 512, Wmkv, li * 512, 0, g_mem + li * 1024, scr, r % I_MKV, lane); continue; } r -= 2 * I_MKV;
            if (r < 2 * I_O) { const int li = r / I_O; p0_transpose_item(w_o + (size_t)li * 1024 * 1024, 1024, 1024, Wo + (size_t)li * 1024 * 1024, 0, 0, nullptr, scr, r % I_O, lane); continue; } r -= 2 * I_O;
            if (r < 4 * I_G) { const int li = r / (2 * I_G), rr = r % (2 * I_G), isup = rr / I_G;
                p0_transpose_item((isup ? w_up : w_gate) + (size_t)li * 1024 * FF, 1024, FF, Wgu + (size_t)li * 5632 * 1024, 0, 1 + isup, g_ffn + li * 1024, scr, rr % I_G, lane); continue; } r -= 4 * I_G;
            { const int li = r / I_D; p0_transpose_item(w_down + (size_t)li * FF * 1024, FF, 1024, Wd + (size_t)li * 1024 * FF, 0, 0, nullptr, scr, r % I_D, lane); }
        }
        for (int m = gw; m < MTOK + MMEM; m += NGW) {
            if (m < MTOK) { const float* xr = m < MPROMPT ? x_prompt + (size_t)m * D : x_sample + (size_t)(m - MPROMPT) * D; row_to_bf16(xr, XB + (size_t)m * D, SS + (size_t)m * 4, lane); }
            else { const int mm = m - MTOK; const float* xr = mm < 8192 ? mem_prompt + (size_t)mm * D : mem_sample + (size_t)(mm - 8192) * D; row_to_bf16(xr, MB + (size_t)mm * D, SSM + (size_t)mm * 4, lane); }
        }
        }
    }
    SEAM(0);

    layer_phases<0>(lds, ldsx, lo, hi_ph, G, bx);
    layer_phases<1>(lds, ldsx, lo, hi_ph, G, bx);
#undef IN
#undef SEAM
}

constexpr int N_PHASES = 13;
extern "C" void kernel_launch(void* const* d_in, const int* in_sizes, int n_in, void* d_out, int out_size, void* d_ws, size_t ws_size, hipStream_t stream) {
    static int grid = 0;
    if (grid == 0) {
        if (n_in != 19 || out_size != MTOK * D || ws_size < WS_END) { fprintf(stderr, "kernel_launch: unexpected shapes n_in %d out %d ws %zu\n", n_in, out_size, ws_size); grid = -1; return; }
        int dev = 0, cus = 0, per_cu = 0;
        if (hipGetDevice(&dev) != hipSuccess || hipDeviceGetAttribute(&cus, hipDeviceAttributeMultiprocessorCount, dev) != hipSuccess) { grid = -1; return; }
        if (hipFuncSetAttribute((const void*)mega_fwd, hipFuncAttributeMaxDynamicSharedMemorySize, LDS_BYTES) != hipSuccess) { fprintf(stderr, "kernel_launch: hipFuncSetAttribute failed\n"); grid = -1; return; }
        if (hipOccupancyMaxActiveBlocksPerMultiprocessor(&per_cu, (const void*)mega_fwd, NWAVES * 64, LDS_BYTES) != hipSuccess || per_cu < 1) { fprintf(stderr, "kernel_launch: occupancy query says %d\n", per_cu); per_cu = 1; }
        (void)hipGetLastError();
        grid = cus * 1;
    }
    if (grid < 0) return;
    if (hipMemsetAsync((char*)d_ws + WS_CTL, 0, CTL_ZERO_BYTES, stream) != hipSuccess) { fprintf(stderr, "kernel_launch: memset failed\n"); return; }
    Args a{};
    for (int i = 0; i < 19; ++i) a.in[i] = (const float*)d_in[i];
    a.out = (float*)d_out; a.ws = (unsigned char*)d_ws;
#if MK_ONE_LAUNCH
    a.ph_lo = 0; a.ph_hi = N_PHASES;
    void* kargs[] = {&a};
    hipError_t e = hipLaunchCooperativeKernel((const void*)mega_fwd, dim3(grid), dim3(NWAVES * 64), kargs, LDS_BYTES, stream);
    if (e != hipSuccess) fprintf(stderr, "cooperative launch failed: %s (grid %d)\n", hipGetErrorString(e), grid);
#else
    for (int p = 0; p < N_PHASES; ++p) { a.ph_lo = p; a.ph_hi = p + 1; hipLaunchKernelGGL(mega_fwd, dim3(grid), dim3(NWAVES * 64), LDS_BYTES, stream, a); }
#endif
}
```

```cpp
#include <hip/hip_runtime.h>
#include <hip/hip_cooperative_groups.h>
#include <cstdio>
#include <cstdint>
namespace cg = cooperative_groups;

#ifndef PROBE_REP
#define PROBE_REP 0
#endif
#define NREP(k) (((PROBE_REP >> (k)) & 1) ? 2 : 1)
#ifndef MK_ONE_LAUNCH
#define MK_ONE_LAUNCH 1
#endif

namespace pg8 {
#define PG8_LAS __attribute__((address_space(3)))
typedef unsigned short bf16_t;
typedef short bf16x8 __attribute__((ext_vector_type(8)));
typedef float f32x4 __attribute__((ext_vector_type(4)));
typedef unsigned u32x4 __attribute__((ext_vector_type(4)));
typedef unsigned u32x2 __attribute__((ext_vector_type(2)));
constexpr int BM = 256, BK = 64, HALF = 128, HTB = HALF * BK * 2, STAGE_BYTES = 8 * HTB, NXCD = 8, WGM = 8;

__host__ __device__ __forceinline__ int lds_byte(int r, int c) { const int st = (r >> 4) * 2 + (c >> 5), rr = r & 15, cc = c & 31, ob = rr * 64 + cc * 2; return st * 1024 + (ob ^ (((ob >> 9) & 1) << 5)); }
__host__ __device__ __forceinline__ void stage_rc(int b, int& R, int& C) { const int st = b / 1024, sb = b % 1024, swz = sb ^ (((sb >> 9) & 1) << 5); R = (st >> 1) * 16 + swz / 64; C = (st & 1) * 32 + (swz % 64) / 2; }
__host__ __device__ __forceinline__ int perm32(int rho) { const int n = rho >> 4, i = rho & 15; return 8 * (i >> 2) + 4 * n + (i & 3); }

__host__ __device__ __forceinline__ size_t ilv_off(int r, int k, int K) { return (size_t)(r >> 4) * (16 * (size_t)K) + (size_t)(r & 7) * (2 * (size_t)K) + (size_t)(k >> 5) * 64 + (size_t)((r >> 3) & 1) * 32 + (k & 31); }
struct Unit { int pm, pn; };
struct Gemm { const bf16_t* A; const bf16_t* Bt; int M, N, K, ailv; };

struct StaticOrder {
    int nM, nN, nwg, G, c;
    __host__ __device__ void init(int M, int N, int G_, int c_) { nM = M / BM; nN = N / BM; nwg = nM * nN; G = G_; c = c_; }
    __host__ __device__ bool next(int i, Unit& u) const {
        const long L = (long)i * G + c; if (L >= nwg) return false;
        int wgid = (int)L; { const int q = nwg / NXCD, r = nwg % NXCD, xcd = wgid % NXCD, off = wgid / NXCD; wgid = (xcd < r ? xcd * (q + 1) : r * (q + 1) + (xcd - r) * q) + off; }
        const int nig = WGM * nN, gid = wgid / nig, fm = gid * WGM, gsz = (nM - fm) < WGM ? (nM - fm) : WGM;
        u.pm = fm + ((wgid % nig) % gsz); u.pn = (wgid % nig) / gsz; return true;
    }
};

__device__ __forceinline__ unsigned cvt_pk_bf16(float lo, float hi) { unsigned r; asm volatile("v_cvt_pk_bf16_f32 %0, %1, %2" : "=v"(r) : "v"(lo), "v"(hi)); return r; }
__device__ __forceinline__ float rstd_of(const float* ss, int row) { const f32x4 p = *(const f32x4*)(ss + (size_t)row * 4); return __builtin_amdgcn_rsqf(((p[0] + p[1]) + (p[2] + p[3])) * (1.0f / 1024.0f) + 1e-6f); }


__device__ __forceinline__ u32x4 xchg8(const u32x4 v) {
    u32x4 r;
#pragma unroll
    for (int i = 0; i < 4; ++i) r[i] = (unsigned)__builtin_amdgcn_update_dpp(0, (int)v[i], 0x128, 0xf, 0xf, true);
    return r;
}
__device__ __forceinline__ u32x4 sel4(bool c, const u32x4 a, const u32x4 b) { u32x4 r; r.x = c ? a.x : b.x; r.y = c ? a.y : b.y; r.z = c ? a.z : b.z; r.w = c ? a.w : b.w; return r; }

struct EpiScaleBf16 {
    static constexpr bool PERM = true;
    bf16_t* O; int ldc; const float* ss;
    __device__ __forceinline__ void operator()(f32x4 (&acc)[2][2][4][2], const Unit& u, int wr, int wc, int fr, int fq) const {
        asm volatile("" : "+v"(fr), "+v"(fq)); asm volatile("" : "+s"(wr), "+s"(wc));
        const bool lo = fr < 8;
        const int row0 = u.pm * BM + wr * 64 + fr, col0 = u.pn * BM + wc * 64 + 8 * fq;
        bf16_t* base = O + (size_t)(u.pm * BM + wr * 64 + (fr & 7)) * ldc + col0 + (lo ? 0 : 32);
#pragma unroll
        for (int ai = 0; ai < 2; ++ai)
#pragma unroll
            for (int m = 0; m < 4; ++m) {
                const float rs = rstd_of(ss, row0 + ai * HALF + m * 16);
                u32x4 w[2];
#pragma unroll
                for (int bj = 0; bj < 2; ++bj) { const f32x4 v0 = acc[ai][bj][m][0] * rs, v1 = acc[ai][bj][m][1] * rs;
                    w[bj].x = cvt_pk_bf16(v0[0], v0[1]); w[bj].y = cvt_pk_bf16(v0[2], v0[3]); w[bj].z = cvt_pk_bf16(v1[0], v1[1]); w[bj].w = cvt_pk_bf16(v1[2], v1[3]); }
                const u32x4 y = xchg8(sel4(lo, w[1], w[0]));
                bf16_t* rp = base + (size_t)(ai * HALF + m * 16) * ldc;
                *(u32x4*)rp = sel4(lo, w[0], y);
                *(u32x4*)(rp + (size_t)8 * ldc) = sel4(lo, y, w[1]);
            }
    }
};

__device__ __forceinline__ f32x4 bf_lo4(unsigned w0, unsigned w1) { return (f32x4){__builtin_bit_cast(float, w0 << 16), __builtin_bit_cast(float, w0 & 0xffff0000u), __builtin_bit_cast(float, w1 << 16), __builtin_bit_cast(float, w1 & 0xffff0000u)}; }
struct EpiResid {
    static constexpr bool PERM = true;
    bf16_t* xb; float* ss; PG8_LAS float* red;
    __device__ __forceinline__ void operator()(f32x4 (&acc)[2][2][4][2], const Unit& u, int wr, int wc, int fr, int fq) const {
        asm volatile("" : "+v"(fr), "+v"(fq)); asm volatile("" : "+s"(wr), "+s"(wc));
        const bool lo = fr < 8;
        const int col0 = u.pn * BM + wc * 64 + 8 * fq;
        bf16_t* base = xb + (size_t)(u.pm * BM + wr * 64 + (fr & 7)) * 1024 + col0 + (lo ? 0 : 32);
#pragma unroll
        for (int ai = 0; ai < 2; ++ai)
#pragma unroll
            for (int m = 0; m < 4; ++m) {
                const int rl = ai * HALF + wr * 64 + m * 16 + fr;
                bf16_t* rp = base + (size_t)(ai * HALF + m * 16) * 1024;
                const u32x4 la = *(const u32x4*)rp, lb = *(const u32x4*)(rp + (size_t)8 * 1024);
                const u32x4 yi = xchg8(sel4(lo, lb, la));
                u32x4 xo[2]; xo[0] = sel4(lo, la, yi); xo[1] = sel4(lo, yi, lb);
                float sq = 0.f; u32x4 w[2];
#pragma unroll
                for (int bj = 0; bj < 2; ++bj) {
                    const f32x4 v0 = acc[ai][bj][m][0] + bf_lo4(xo[bj].x, xo[bj].y), v1 = acc[ai][bj][m][1] + bf_lo4(xo[bj].z, xo[bj].w);
                    sq += (v0[0] * v0[0] + v0[1] * v0[1]) + (v0[2] * v0[2] + v0[3] * v0[3]) + (v1[0] * v1[0] + v1[1] * v1[1]) + (v1[2] * v1[2] + v1[3] * v1[3]);
                    w[bj].x = cvt_pk_bf16(v0[0], v0[1]); w[bj].y = cvt_pk_bf16(v0[2], v0[3]); w[bj].z = cvt_pk_bf16(v1[0], v1[1]); w[bj].w = cvt_pk_bf16(v1[2], v1[3]);
                }
                const u32x4 yo = xchg8(sel4(lo, w[1], w[0]));
                *(u32x4*)rp = sel4(lo, w[0], yo); *(u32x4*)(rp + (size_t)8 * 1024) = sel4(lo, yo, w[1]);
                sq += __shfl_xor(sq, 16); sq += __shfl_xor(sq, 32);
                if (fq == 0) red[rl * 4 + wc] = sq;
            }
        asm volatile("s_waitcnt lgkmcnt(0)" ::: "memory"); __builtin_amdgcn_s_barrier(); asm volatile("" ::: "memory");
        const int tid = threadIdx.x;
        if (tid < 256) { const f32x4 p = *(const PG8_LAS f32x4*)(red + tid * 4); ss[(size_t)(u.pm * BM + tid) * 4 + u.pn] = (p[0] + p[1]) + (p[2] + p[3]); }
    }
};

struct EpiFinal {
    static constexpr bool PERM = true;
    const bf16_t* xb; float* xout; const float* gfin; float* xs; unsigned* cnt; PG8_LAS float* red;
    __device__ __forceinline__ void operator()(f32x4 (&acc)[2][2][4][2], const Unit& u, int wr, int wc, int fr, int fq) const {
        asm volatile("" : "+v"(fr), "+v"(fq)); asm volatile("" : "+s"(wr), "+s"(wc));
        const bool lo = fr < 8;
        const int col0 = u.pn * BM + wc * 64 + 8 * fq;
#pragma unroll
        for (int ai = 0; ai < 2; ++ai)
#pragma unroll
            for (int m = 0; m < 4; ++m) {
                const int rl = ai * HALF + wr * 64 + m * 16 + fr;
                const bf16_t* rp = xb + (size_t)(u.pm * BM + wr * 64 + (fr & 7) + ai * HALF + m * 16) * 1024 + col0 + (lo ? 0 : 32);
                const u32x4 la = *(const u32x4*)rp, lb = *(const u32x4*)(rp + (size_t)8 * 1024);
                const u32x4 yi = xchg8(sel4(lo, lb, la));
                u32x4 xo2[2]; xo2[0] = sel4(lo, la, yi); xo2[1] = sel4(lo, yi, lb);
                float sq = 0.f;
#pragma unroll
                for (int bj = 0; bj < 2; ++bj) {
                    const u32x4 xo = xo2[bj];
                    const f32x4 v0 = acc[ai][bj][m][0] + bf_lo4(xo.x, xo.y), v1 = acc[ai][bj][m][1] + bf_lo4(xo.z, xo.w);
                    sq += (v0[0] * v0[0] + v0[1] * v0[1]) + (v0[2] * v0[2] + v0[3] * v0[3]) + (v1[0] * v1[0] + v1[1] * v1[1]) + (v1[2] * v1[2] + v1[3] * v1[3]);
                    acc[ai][bj][m][0] = v0; acc[ai][bj][m][1] = v1;
                }
                sq += __shfl_xor(sq, 16); sq += __shfl_xor(sq, 32);
                if (fq == 0) red[rl * 4 + wc] = sq;
            }
        asm volatile("s_waitcnt lgkmcnt(0)" ::: "memory"); __builtin_amdgcn_s_barrier(); asm volatile("" ::: "memory");
        const int tid = threadIdx.x;
        unsigned* cw_ = cnt + 64 * u.pm;
        if (tid < 256) {
            const f32x4 p = *(const PG8_LAS f32x4*)(red + tid * 4);
            __hip_atomic_store(xs + (size_t)(u.pm * 4 + u.pn) * 256 + tid, (p[0] + p[1]) + (p[2] + p[3]), __ATOMIC_RELAXED, __HIP_MEMORY_SCOPE_AGENT);
            asm volatile("s_waitcnt vmcnt(0)" ::: "memory");
            if ((tid & 63) == 0) __hip_atomic_fetch_add(cw_, 1u, __ATOMIC_RELAXED, __HIP_MEMORY_SCOPE_AGENT);
        }
        if (tid < 64) {
            unsigned sp = 0u;
            while ((unsigned)__builtin_amdgcn_readfirstlane(__hip_atomic_load(cw_, __ATOMIC_RELAXED, __HIP_MEMORY_SCOPE_AGENT)) < 16u) { __builtin_amdgcn_s_sleep(2); if (++sp > (1u << 24)) break; }
            __builtin_amdgcn_fence(__ATOMIC_ACQUIRE, "agent");
        }
        asm volatile("s_waitcnt vmcnt(0) lgkmcnt(0)" ::: "memory"); __builtin_amdgcn_s_barrier(); asm volatile("" ::: "memory");
        if (tid < 256) {
            const float* xp = xs + (size_t)(u.pm * 4) * 256 + tid;
            const float t0 = __hip_atomic_load(xp, __ATOMIC_RELAXED, __HIP_MEMORY_SCOPE_AGENT), t1 = __hip_atomic_load(xp + 256, __ATOMIC_RELAXED, __HIP_MEMORY_SCOPE_AGENT),
                        t2 = __hip_atomic_load(xp + 512, __ATOMIC_RELAXED, __HIP_MEMORY_SCOPE_AGENT), t3 = __hip_atomic_load(xp + 768, __ATOMIC_RELAXED, __HIP_MEMORY_SCOPE_AGENT);
            red[1024 + tid] = __builtin_amdgcn_rsqf(((t0 + t1) + (t2 + t3)) * (1.0f / 1024.0f) + 1e-6f);
        }
        asm volatile("s_waitcnt lgkmcnt(0)" ::: "memory"); __builtin_amdgcn_s_barrier(); asm volatile("" ::: "memory");
        f32x4 gv[2][2];
#pragma unroll
        for (int bj = 0; bj < 2; ++bj) { gv[bj][0] = *(const f32x4*)(gfin + col0 + bj * 32); gv[bj][1] = *(const f32x4*)(gfin + col0 + bj * 32 + 4); }
#pragma unroll
        for (int ai = 0; ai < 2; ++ai)
#pragma unroll
            for (int m = 0; m < 4; ++m) {
                const int rl = ai * HALF + wr * 64 + m * 16 + fr;
                const float rs = red[1024 + rl];
                float* xo = xout + (size_t)(u.pm * BM + wr * 64 + (fr & 7) + ai * HALF + m * 16) * 1024 + col0 + (lo ? 0 : 4);
#pragma unroll
                for (int bj = 0; bj < 2; ++bj) {
                    const f32x4 w0 = acc[ai][bj][m][0] * rs * gv[bj][0], w1 = acc[ai][bj][m][1] * rs * gv[bj][1];
                    const u32x4 u0 = __builtin_bit_cast(u32x4, w0), u1 = __builtin_bit_cast(u32x4, w1);
                    const u32x4 y = xchg8(sel4(lo, u1, u0));
                    *(u32x4*)(xo + bj * 32) = sel4(lo, u0, y);
                    *(u32x4*)(xo + (size_t)8 * 1024 + bj * 32) = sel4(lo, y, u1);
                }
            }
    }
};

struct EpiGateUp {
    static constexpr bool PERM = true;
    bf16_t* act; const float* ss; const float* cw; const float* cb; float* sb; PG8_LAS float* edge;
    __device__ __forceinline__ void operator()(f32x4 (&acc)[2][2][4][2], const Unit& u, int wr, int wc, int fr, int fq) const {
        asm volatile("" : "+v"(fr), "+v"(fq)); asm volatile("" : "+s"(wr), "+s"(wc));
        const int slot0 = wc * 32 + 8 * fq, fcol0 = u.pn * 128 + slot0;
#pragma unroll
        for (int ai = 0; ai < 2; ++ai)
#pragma unroll
            for (int m = 0; m < 4; ++m) {
                const float rs = rstd_of(ss, u.pm * BM + ai * HALF + wr * 64 + m * 16 + fr);
#pragma unroll
                for (int bj = 0; bj < 2; ++bj)
#pragma unroll
                    for (int n = 0; n < 2; ++n) acc[ai][bj][m][n] = acc[ai][bj][m][n] * rs;
            }
        PG8_LAS float* eB = edge + slot0, * eT = edge + 17 * 128 + slot0;
        if (fr == 0 || fr == 15) {
            PG8_LAS float* e0 = (fr == 15 ? eB + 128 : eT) + wr * 4 * 128;
#pragma unroll
            for (int ai = 0; ai < 2; ++ai)
#pragma unroll
                for (int m = 0; m < 4; ++m) { *(PG8_LAS f32x4*)(e0 + (ai * 8 + m) * 128) = acc[ai][0][m][0]; *(PG8_LAS f32x4*)(e0 + (ai * 8 + m) * 128 + 4) = acc[ai][0][m][1]; }
        }
        asm volatile("s_waitcnt lgkmcnt(0)" ::: "memory"); __builtin_amdgcn_s_barrier(); asm volatile("" ::: "memory");
        const PG8_LAS float* rB = eB + wr * 4 * 128, * rT = eT + (wr * 4 + 1) * 128;
        const int rowb = u.pm * BM + wr * 64 + fr;
        u32x2 keep[2][4];
#pragma unroll
        for (int n = 0; n < 2; ++n) {
            const f32x4 w0 = *(const f32x4*)(cw + fcol0 + 4 * n), w1 = *(const f32x4*)(cw + 2816 + fcol0 + 4 * n), w2 = *(const f32x4*)(cw + 5632 + fcol0 + 4 * n), bb = *(const f32x4*)(cb + fcol0 + 4 * n);
#pragma unroll
            for (int ai = 0; ai < 2; ++ai)
#pragma unroll
                for (int m = 0; m < 4; ++m) {
                    const f32x4 ep = *(const PG8_LAS f32x4*)(rB + (ai * 8 + m) * 128 + 4 * n), en = *(const PG8_LAS f32x4*)(rT + (ai * 8 + m) * 128 + 4 * n);
                    f32x4 cv, av;
#pragma unroll
                    for (int e = 0; e < 4; ++e) {
                        const float g = acc[ai][0][m][n][e];
                        const float up = __builtin_bit_cast(float, __builtin_amdgcn_update_dpp(0, __builtin_bit_cast(int, g), 0x111, 0xf, 0xf, true));
                        const float dn = __builtin_bit_cast(float, __builtin_amdgcn_update_dpp(0, __builtin_bit_cast(int, g), 0x101, 0xf, 0xf, true));
                        const float prev = (fr == 0) ? ep[e] : up, next = (fr == 15) ? en[e] : dn;
                        const float c = w0[e] * prev + w1[e] * g + w2[e] * next + bb[e];
                        const float sg = __builtin_amdgcn_rcpf(1.0f + __builtin_amdgcn_exp2f(-1.4426950408889634f * c));
                        cv[e] = c; av[e] = c * sg * acc[ai][1][m][n][e];
                    }
                    const bool seam = (ai == 0 && m == 0) ? (wr == 0 && fr == 0) : ((ai == 1 && m == 3) ? (wr == 1 && fr == 15) : false);
                    if (seam) {
                        float* s = sb + (size_t)((u.pm * 2 + ai) * 3) * 2816 + fcol0 + 4 * n;
                        *(f32x4*)(s) = acc[ai][0][m][n]; *(f32x4*)(s + 2816) = cv; *(f32x4*)(s + 5632) = acc[ai][1][m][n];
                    }
                    {
                        u32x2 w; w.x = cvt_pk_bf16(av[0], av[1]); w.y = cvt_pk_bf16(av[2], av[3]);
                        if (n == 0) keep[ai][m] = w;
                        else if (!seam) { u32x4 w4; w4.x = keep[ai][m].x; w4.y = keep[ai][m].y; w4.z = w.x; w4.w = w.y; *(u32x4*)(act + ilv_off(rowb + ai * HALF + m * 16, fcol0, 2816)) = w4; }
                    }
                }
        }
    }
};

template <class Epi, class Sched, bool ALIGN_EPI = true, bool SP2 = true>
__device__ __forceinline__ void gemm_phase(PG8_LAS unsigned char* lds, const Gemm g, const Sched& S, const Epi& E) {
    int tid = threadIdx.x; asm volatile("" : "+v"(tid));
    const int wid = __builtin_amdgcn_readfirstlane(tid >> 6), lane = tid & 63, wr = wid >> 2, wc = wid & 3, fr = lane & 15, fq = lane >> 4;
    const int K = g.K, nt = K / BK;
    unsigned voffA[2], voffB[2];
#pragma unroll
    for (int i = 0; i < 2; ++i) { int R, C; stage_rc(tid * 16 + i * 8192, R, C); const int Rb = Epi::PERM ? (64 * (R >> 5) + perm32(R & 31)) : R;
        voffA[i] = g.ailv ? (unsigned)ilv_off(R, C, K) * 2u : (unsigned)(R * K + C) * 2u; voffB[i] = (unsigned)(Rb * K + C) * 2u; }
    const size_t kstep = (size_t)(BK * 2), kstepA = g.ailv ? 2 * kstep : kstep;
    const size_t hstepA = (size_t)HALF * K * 2, hstepB = (size_t)32 * K * 2;
    const size_t tstep = 2 * hstepA;
    const unsigned ldsw = (unsigned)wid * 1024u;
    const int aoff = lds_byte(wr * 64 + fr, fq * 8), boff = lds_byte(wc * 32 + fr, fq * 8);
#define PG8_SA(b, h) (((b) * 2 + (h)) * HTB)
#define PG8_SB(b, h) ((4 + (b) * 2 + (h)) * HTB)
#define PG8_STAGE(bufoff, gbase, voff) do { _Pragma("unroll") for (int _i = 0; _i < 2; ++_i) \
        __builtin_amdgcn_global_load_lds((const unsigned*)((const char*)(gbase) + (voff)[_i]), (PG8_LAS unsigned*)(lds + (bufoff) + ldsw + _i * 8192), 16, 0, 0); } while (0)
#define PG8_LDA(dst, b, h) do { _Pragma("unroll") for (int m = 0; m < 4; ++m) _Pragma("unroll") for (int k = 0; k < 2; ++k) dst[m][k] = *(const PG8_LAS bf16x8*)(lds + PG8_SA(b, h) + aoff + m * 2048 + k * 1024); } while (0)
#define PG8_LDB(dst, b, h) do { _Pragma("unroll") for (int n = 0; n < 2; ++n) _Pragma("unroll") for (int k = 0; k < 2; ++k) dst[n][k] = *(const PG8_LAS bf16x8*)(lds + PG8_SB(b, h) + boff + n * 2048 + k * 1024); } while (0)
#define PG8_MMA(ai, bj, At, Bt) do { __builtin_amdgcn_s_setprio(1); _Pragma("unroll") for (int m = 0; m < 4; ++m) _Pragma("unroll") for (int n = 0; n < 2; ++n) _Pragma("unroll") for (int k = 0; k < 2; ++k) \
        acc[ai][bj][m][n] = __builtin_amdgcn_mfma_f32_16x16x32_bf16(Bt[n][k], At[m][k], acc[ai][bj][m][n], 0, 0, 0); __builtin_amdgcn_s_setprio(0); } while (0)
#define PG8_WAIT_V(n) asm volatile("s_waitcnt vmcnt(" #n ")" ::: "memory")
#define PG8_WAIT_L(n) asm volatile("s_waitcnt lgkmcnt(" #n ")" ::: "memory")
#define PG8_BAR __builtin_amdgcn_s_barrier()
#define PG8_SCHED __builtin_amdgcn_sched_barrier(0)
    Unit cur, nxt; int ui = 0;
    if (!S.next(0, cur)) return;
    f32x4 acc[2][2][4][2];
#pragma unroll
    for (int a = 0; a < 2; ++a)
#pragma unroll
        for (int b = 0; b < 2; ++b)
#pragma unroll
            for (int m = 0; m < 4; ++m)
#pragma unroll
                for (int n = 0; n < 2; ++n) acc[a][b][m][n] = (f32x4){0.f, 0.f, 0.f, 0.f};
    bf16x8 At[4][2], B0[2][2], B1[2][2];
    const char* cA = (const char*)g.A + (size_t)cur.pm * tstep; const char* cB = (const char*)g.Bt + (size_t)cur.pn * tstep;
    if constexpr (SP2) {
        PG8_STAGE(PG8_SB(0, 0), cB, voffB); PG8_STAGE(PG8_SB(0, 1), cB + hstepB, voffB); PG8_STAGE(PG8_SA(0, 0), cA, voffA); PG8_STAGE(PG8_SA(0, 1), cA + hstepA, voffA);
        if (wr == 1) PG8_BAR;
        PG8_WAIT_V(2); PG8_BAR;
        PG8_STAGE(PG8_SB(1, 0), cB + kstep, voffB); PG8_STAGE(PG8_SA(1, 0), cA + kstepA, voffA); PG8_STAGE(PG8_SB(1, 1), cB + hstepB + kstep, voffB);
        PG8_WAIT_V(6); PG8_BAR;
    } else {
        PG8_STAGE(PG8_SB(0, 0), cB, voffB); PG8_STAGE(PG8_SA(0, 0), cA, voffA); PG8_STAGE(PG8_SB(0, 1), cB + hstepB, voffB); PG8_STAGE(PG8_SA(0, 1), cA + hstepA, voffA);
        if (wr == 1) PG8_BAR;
        PG8_WAIT_V(4); PG8_BAR;
        PG8_STAGE(PG8_SB(1, 0), cB + kstep, voffB); PG8_STAGE(PG8_SA(1, 0), cA + kstepA, voffA); PG8_STAGE(PG8_SB(1, 1), cB + hstepB + kstep, voffB);
        PG8_WAIT_V(6); PG8_BAR;
    }
    for (;;) {
        const bool has_next = S.next(ui + 1, nxt);
        const char* nA = has_next ? (const char*)g.A + (size_t)nxt.pm * tstep : cA; const char* nB = has_next ? (const char*)g.Bt + (size_t)nxt.pn * tstep : cB;
        for (int t = 0; t < nt; t += 2) {
            const bool last = (t == nt - 2);
            const char* a1 = cA + (size_t)(t + 1) * kstepA;
            const char* a2 = last ? nA : cA + (size_t)(t + 2) * kstepA; const char* b2 = last ? nB : cB + (size_t)(t + 2) * kstep;
            const char* a3 = a2 + kstepA; const char* b3 = b2 + kstep;
            if constexpr (SP2) {
            PG8_LDB(B0, 0, 0); PG8_LDB(B1, 0, 1); PG8_SCHED; PG8_LDA(At, 0, 0); PG8_STAGE(PG8_SA(1, 1), a1 + hstepA, voffA);
            PG8_WAIT_V(8); PG8_WAIT_L(0); PG8_BAR; PG8_MMA(0, 0, At, B0); PG8_MMA(0, 1, At, B1); PG8_BAR; PG8_SCHED;
            PG8_LDA(At, 0, 1); PG8_STAGE(PG8_SB(0, 0), b2, voffB); PG8_STAGE(PG8_SB(0, 1), b2 + hstepB, voffB); PG8_STAGE(PG8_SA(0, 0), a2, voffA);
            PG8_WAIT_V(8); PG8_WAIT_L(0); PG8_BAR; PG8_MMA(1, 0, At, B0); PG8_MMA(1, 1, At, B1); PG8_BAR; PG8_SCHED;
            PG8_LDB(B0, 1, 0); PG8_LDB(B1, 1, 1); PG8_SCHED; PG8_LDA(At, 1, 0); PG8_STAGE(PG8_SA(0, 1), a2 + hstepA, voffA);
            PG8_WAIT_V(8); PG8_WAIT_L(0); PG8_BAR; PG8_MMA(0, 0, At, B0); PG8_MMA(0, 1, At, B1); PG8_BAR; PG8_SCHED;
            PG8_LDA(At, 1, 1); PG8_STAGE(PG8_SB(1, 0), b3, voffB); PG8_STAGE(PG8_SB(1, 1), b3 + hstepB, voffB); PG8_STAGE(PG8_SA(1, 0), a3, voffA);
            PG8_WAIT_V(8); PG8_WAIT_L(0); PG8_BAR; PG8_MMA(1, 0, At, B0); PG8_MMA(1, 1, At, B1); PG8_BAR; PG8_SCHED;
            } else {
            PG8_LDB(B0, 0, 0); PG8_SCHED; PG8_LDA(At, 0, 0); PG8_STAGE(PG8_SA(1, 1), a1 + hstepA, voffA);
            PG8_WAIT_L(8); PG8_BAR; PG8_WAIT_L(0); PG8_MMA(0, 0, At, B0); PG8_BAR; PG8_SCHED;
            PG8_LDB(B1, 0, 1); PG8_STAGE(PG8_SB(0, 0), b2, voffB);
            PG8_BAR; PG8_WAIT_L(0); PG8_MMA(0, 1, At, B1); PG8_BAR;
            PG8_LDA(At, 0, 1); PG8_STAGE(PG8_SA(0, 0), a2, voffA);
            PG8_BAR; PG8_WAIT_L(0); PG8_MMA(1, 0, At, B0); PG8_BAR; PG8_SCHED;
            PG8_STAGE(PG8_SB(0, 1), b2 + hstepB, voffB);
            PG8_WAIT_V(6); PG8_BAR; PG8_MMA(1, 1, At, B1); PG8_BAR;
            PG8_LDB(B0, 1, 0); PG8_SCHED; PG8_LDA(At, 1, 0); PG8_STAGE(PG8_SA(0, 1), a2 + hstepA, voffA);
            PG8_WAIT_L(8); PG8_BAR; PG8_WAIT_L(0); PG8_MMA(0, 0, At, B0); PG8_BAR; PG8_SCHED;
            PG8_LDB(B1, 1, 1); PG8_STAGE(PG8_SB(1, 0), b3, voffB);
            PG8_BAR; PG8_WAIT_L(0); PG8_MMA(0, 1, At, B1); PG8_BAR;
            PG8_LDA(At, 1, 1); PG8_STAGE(PG8_SA(1, 0), a3, voffA);
            PG8_BAR; PG8_WAIT_L(0); PG8_MMA(1, 0, At, B0); PG8_BAR; PG8_SCHED;
            PG8_STAGE(PG8_SB(1, 1), b3 + hstepB, voffB);
            PG8_WAIT_V(6); PG8_BAR; PG8_MMA(1, 1, At, B1); PG8_BAR;
            }
        }
        if constexpr (ALIGN_EPI) { if (wr == 0) PG8_BAR; }
        E(acc, cur, wr, wc, fr, fq);
        if (!has_next) break;
#pragma unroll
        for (int a = 0; a < 2; ++a)
#pragma unroll
            for (int b = 0; b < 2; ++b)
#pragma unroll
                for (int m = 0; m < 4; ++m)
#pragma unroll
                    for (int n = 0; n < 2; ++n) acc[a][b][m][n] = (f32x4){0.f, 0.f, 0.f, 0.f};
        cur = nxt; cA = nA; cB = nB; ++ui;
        if constexpr (ALIGN_EPI) { if (wr == 1) PG8_BAR; }
    }
    PG8_WAIT_V(0);
    if constexpr (!ALIGN_EPI) { if (wr == 0) PG8_BAR; }
    PG8_BAR;
#undef PG8_SA
#undef PG8_SB
#undef PG8_STAGE
#undef PG8_LDA
#undef PG8_LDB
#undef PG8_MMA
#undef PG8_WAIT_V
#undef PG8_WAIT_L
#undef PG8_BAR
#undef PG8_SCHED
}
}

#define LAS __attribute__((address_space(3)))
#define CAS __attribute__((address_space(4)))
typedef unsigned short bf16;
typedef float f32x4 __attribute__((ext_vector_type(4)));
typedef float f32x16 __attribute__((ext_vector_type(16)));
typedef short bf16x8 __attribute__((ext_vector_type(8)));
typedef short s16x4 __attribute__((ext_vector_type(4)));
typedef unsigned u32x4 __attribute__((ext_vector_type(4)));
typedef unsigned u32x2 __attribute__((ext_vector_type(2)));

constexpr int D = 1024, MTOK = 81920, MPROMPT = 65536, MMEM = 8448, FF = 2816;
constexpr int NTILE = MTOK / 256;
constexpr size_t MiB = 1u << 20;
constexpr size_t WS_CTL = 0, CTL_ZERO_BYTES = 131072;
constexpr int CW_PANEL = 4096;
constexpr size_t WS_XS = 110 * MiB + 768 * 1024;
constexpr size_t WS_WINA = 1 * MiB, WS_WINB = 4 * MiB, WS_WMKV = 9 * MiB, WS_WO = 11 * MiB, WS_WGU = 15 * MiB, WS_WD = 37 * MiB;
constexpr size_t WS_SS = 49 * MiB, WS_SSM = 55 * MiB, WS_MB = 56 * MiB, WS_MKV = 73 * MiB, WS_SB = 90 * MiB;
constexpr size_t WS_XB = 112 * MiB, WS_PROJ = 272 * MiB, WS_O = 672 * MiB, WS_ACT = 272 * MiB, WS_END = 832 * MiB;
static_assert(WS_WINA + (size_t)1536 * 1024 * 2 <= WS_WINB && WS_WINB + (size_t)2560 * 1024 * 2 <= WS_WMKV && WS_WMKV + (size_t)1024 * 1024 * 2 <= WS_WO && WS_WO + (size_t)2 * 1024 * 1024 * 2 <= WS_WGU &&
              WS_WGU + (size_t)2 * 5632 * 1024 * 2 <= WS_WD && WS_WD + (size_t)2 * 1024 * 2816 * 2 <= WS_SS && WS_SS + (size_t)MTOK * 16 <= WS_SSM && WS_SSM + (size_t)MMEM * 16 <= WS_MB &&
              WS_MB + (size_t)MMEM * 1024 * 2 <= WS_MKV && WS_MKV + (size_t)MMEM * 1024 * 2 <= WS_SB && WS_SB + (size_t)NTILE * 6 * FF * 4 <= WS_XB && WS_XB + (size_t)MTOK * 1024 * 2 <= WS_PROJ &&
              WS_PROJ + (size_t)MTOK * 2560 * 2 <= WS_O && WS_O + (size_t)MTOK * 1024 * 2 <= WS_END && WS_ACT + (size_t)MTOK * FF * 2 <= WS_END, "d_ws map");

static_assert((CW_PANEL + 64 * 320) * 4 <= (int)CTL_ZERO_BYTES && WS_SB + (size_t)NTILE * 6 * FF * 4 <= WS_XS && WS_XS + (size_t)320 * 4 * 256 * 4 <= WS_XB, "ctl / exchange map");
constexpr int LDS_X_OFF = 131072;
constexpr int MISC_OFF = 131072 + 2 * 17 * 128 * 4 + 512;
constexpr int LDS_BYTES = 131072 + 2 * 17 * 128 * 4 + 1024;
constexpr int NWAVES = 8;

__device__ __forceinline__ unsigned f2bf(float f) { unsigned u = __builtin_bit_cast(unsigned, f); return (u + 0x7fffu + ((u >> 16) & 1u)) >> 16; }
__device__ __forceinline__ unsigned pk2(float lo, float hi) { return f2bf(lo) | (f2bf(hi) << 16); }
__device__ __forceinline__ float wave_sum(float v) {
#pragma unroll
    for (int o = 1; o < 64; o <<= 1) v += __shfl_xor(v, o);
    return v;
}

#define XB_TMO      128
#define XB_XCNT(j)  (256  + 64 * (j))
#define XB_XSUB(j)  (1280 + 64 * (j))
#define XB_XGEN(j)  (2304 + 64 * (j))
#define XB_TOP      3328
#define XB_TOPGEN   3392
#define XCD_BAR_WORDS 3456
#define XB_SPIN_CAP (1u << 22)
__device__ __forceinline__ unsigned xb_ld(unsigned* p)              { return __hip_atomic_load(p, __ATOMIC_RELAXED, __HIP_MEMORY_SCOPE_AGENT); }
__device__ __forceinline__ unsigned xb_add(unsigned* p, unsigned v) { return __hip_atomic_fetch_add(p, v, __ATOMIC_RELAXED, __HIP_MEMORY_SCOPE_AGENT); }
__device__ __forceinline__ unsigned xb_xcc_id() { return (unsigned)__builtin_amdgcn_s_getreg((3 << 11) | 20) & 0xFu; }
#define XB_SPIN(cond, bar) do { unsigned _sp = 0; while (cond) { __builtin_amdgcn_s_sleep(1); \
    if ((++_sp & 255u) == 0u) { if (xb_ld(&(bar)[XB_TMO])) break; if (_sp > XB_SPIN_CAP) { atomicAdd(&(bar)[XB_TMO], 1u); break; } } } } while (0)
__device__ __forceinline__ void xcd_barrier_complete(unsigned* bar, unsigned x, unsigned& nloc, unsigned& nx) {
    const unsigned G = gridDim.x * gridDim.y * gridDim.z;
    unsigned sum, cnt, mine, sp = 0u;
    for (;;) {
        sum = 0u; cnt = 0u; mine = 0u;
#pragma unroll
        for (unsigned j = 0; j < 16; ++j) { const unsigned c = xb_ld(&bar[XB_XCNT(j)]); sum += c; cnt += (c > 0u) ? 1u : 0u; mine = (j == x) ? c : mine; }
        if (sum == G) break;
        __builtin_amdgcn_s_sleep(1);
        if ((++sp & 255u) == 0u) { if (xb_ld(&bar[XB_TMO])) break; if (sp > XB_SPIN_CAP) { atomicAdd(&bar[XB_TMO], 1u); break; } }
    }
    nloc = mine > 0u ? mine : 1u; nx = cnt > 0u ? cnt : 1u;
}
__device__ __forceinline__ void xcd_barrier(unsigned* bar, volatile __attribute__((address_space(3))) unsigned* st) {
    asm volatile("s_waitcnt vmcnt(0)" ::: "memory");
    __syncthreads();
    if (threadIdx.x == 0) {
        const unsigned x = xb_xcc_id();
        __builtin_amdgcn_s_waitcnt(0);
        unsigned nloc = st[0], nx = st[1];
        if (nloc == 0u) { xcd_barrier_complete(bar, x, nloc, nx); st[0] = nloc; st[1] = nx; }
        const unsigned old = xb_add(&bar[XB_XSUB(x)], 1u);
        const unsigned gen = old / nloc;
        if (old + 1u == (gen + 1u) * nloc) {
            __builtin_amdgcn_fence(__ATOMIC_RELEASE, "agent");
            asm volatile("s_waitcnt vmcnt(0)" ::: "memory");
            const unsigned og = xb_add(&bar[XB_TOP], 1u);
            const unsigned tg = og / nx;
            if (og + 1u == (tg + 1u) * nx) xb_add(&bar[XB_TOPGEN], 1u);
            else XB_SPIN(xb_ld(&bar[XB_TOPGEN]) == tg, bar);
            __builtin_amdgcn_fence(__ATOMIC_ACQUIRE, "agent");
            xb_add(&bar[XB_XGEN(x)], 1u);
            asm volatile("s_waitcnt vmcnt(0)" ::: "memory");
        } else {
            XB_SPIN(xb_ld(&bar[XB_XGEN(x)]) == gen, bar);
            __builtin_amdgcn_fence(__ATOMIC_ACQUIRE, "agent");
            asm volatile("s_waitcnt vmcnt(0)" ::: "memory");
        }
    }
    __syncthreads();
}

__device__ __forceinline__ void p0_transpose_item(const float* W, int K, int N, bf16* WT, int row_off, int mode, const float* gain, LAS float* scr, int item, int lane) {
    const int nblk = N / 32, kb = item / nblk, nb = item % nblk, k0 = 64 * kb, n0 = 32 * nb;
#pragma unroll 8
    for (int i = 0; i < 32; ++i) { const int kk = 2 * i + (lane >> 5); float v = W[(size_t)(k0 + kk) * N + n0 + (lane & 31)]; if (gain) v *= gain[k0 + kk]; scr[kk * 33 + (lane & 31)] = v; }
    asm volatile("s_waitcnt lgkmcnt(0)" ::: "memory");
    const int c = lane & 7;
    const int drow0 = (mode == 0) ? row_off + n0 : (n0 / 128) * 256 + ((n0 % 128) / 32) * 64 + (mode - 1) * 32;
#pragma unroll
    for (int j = 0; j < 4; ++j) { const int n = (lane >> 3) + 8 * j; const LAS float* s = scr + (8 * c) * 33 + n;
        u32x4 o; o.x = pk2(s[0 * 33], s[1 * 33]); o.y = pk2(s[2 * 33], s[3 * 33]); o.z = pk2(s[4 * 33], s[5 * 33]); o.w = pk2(s[6 * 33], s[7 * 33]);
        *(u32x4*)(WT + (size_t)(drow0 + n) * K + k0 + 8 * c) = o; }
    asm volatile("s_waitcnt lgkmcnt(0)" ::: "memory");
}
template <int L> __device__ __forceinline__ void convert_layer_weights(const float* const (&in)[19], unsigned char* ws, LAS float* scr, int start, int stride, int lane);
__device__ __forceinline__ void row_to_bf16(const float* xrow, bf16* orow, float* ssrow, int lane) {
    const f32x4* xr = (const f32x4*)xrow + lane;
    f32x4 v[4]; float s = 0.f;
#pragma unroll
    for (int j = 0; j < 4; ++j) { v[j] = xr[64 * j]; s += (v[j].x * v[j].x + v[j].y * v[j].y) + (v[j].z * v[j].z + v[j].w * v[j].w); }
    s = wave_sum(s);
    u32x2* o8 = (u32x2*)orow + lane;
#pragma unroll
    for (int j = 0; j < 4; ++j) { u32x2 w; w.x = pk2(v[j].x, v[j].y); w.y = pk2(v[j].z, v[j].w); o8[64 * j] = w; }
    if (lane == 0) *(f32x4*)ssrow = (f32x4){s, 0.f, 0.f, 0.f};
}

struct Args {
    const float* in[19]; float* out; unsigned char* ws; int ph_lo, ph_hi;
};

template <int L> __device__ __forceinline__ void convert_layer_weights(const float* const (&in)[19], unsigned char* ws, LAS float* scr, int start, int stride, int lane) {
    const float* g_mix = in[4]; const float* g_mem = in[5]; const float* w_in = L == 0 ? in[6] : in[8]; const float* w_mem_kv = in[10]; const float* w_o = in[11];
    const float* g_ffn = in[12]; const float* w_gate = in[13]; const float* w_up = in[14]; const float* w_down = in[17];
    bf16* Win = (bf16*)(ws + (L == 0 ? WS_WINA : WS_WINB)); bf16* Wmkv = (bf16*)(ws + WS_WMKV); bf16* Wo = (bf16*)(ws + WS_WO); bf16* Wgu = (bf16*)(ws + WS_WGU); bf16* Wd = (bf16*)(ws + WS_WD);
    constexpr int NIN = L == 0 ? 1536 : 2560, I_IN = 16 * (NIN / 32), I_MKV = 16 * 16, I_O = 16 * 32, I_G = 16 * 88, I_D = 44 * 32, NIT = I_IN + I_MKV + I_O + 2 * I_G + I_D;
    for (int it = start; it < NIT; it += stride) {
        int r = it;
        if (r < I_IN) { p0_transpose_item(w_in, 1024, NIN, Win, 0, 0, g_mix + L * 1024, scr, r, lane); continue; } r -= I_IN;
        if (r < I_MKV) { p0_transpose_item(w_mem_kv + (size_t)L * 1024 * 512, 1024, 512, Wmkv, L * 512, 0, g_mem + L * 1024, scr, r, lane); continue; } r -= I_MKV;
        if (r < I_O) { p0_transpose_item(w_o + (size_t)L * 1024 * 1024, 1024, 1024, Wo + (size_t)L * 1024 * 1024, 0, 0, nullptr, scr, r, lane); continue; } r -= I_O;
        if (r < 2 * I_G) { const int isup = r / I_G; p0_transpose_item((isup ? w_up : w_gate) + (size_t)L * 1024 * FF, 1024, FF, Wgu + (size_t)L * 5632 * 1024, 0, 1 + isup, g_ffn + L * 1024, scr, r % I_G, lane); continue; } r -= 2 * I_G;
        p0_transpose_item(w_down + (size_t)L * FF * 1024, FF, 1024, Wd + (size_t)L * 1024 * FF, 0, 0, nullptr, scr, r, lane);
    }
}

constexpr float LOG2E = 1.4426950408889634f;
constexpr float CSC = 0.125f * LOG2E;
#define MFMA32(a, b, c) __builtin_amdgcn_mfma_f32_32x32x16_bf16((a), (b), (c), 0, 0, 0)
__device__ __forceinline__ int crow(int i, int hi) { return (i & 3) + 8 * (i >> 2) + 4 * hi; }

template <int UN> struct VRegs { u32x4 a[UN], b[UN]; };
template <int UN> __device__ __forceinline__ void vt_load(VRegs<UN>& R, const bf16* Vbase, int pitch, int gk0, int kl_lo, int kl_hi) {
    const int npair = (kl_hi - kl_lo) >> 1, total = npair * 8;
    const unsigned rcp = (1u << 24) / (unsigned)npair + 1u;
#pragma unroll
    for (int uu = 0; uu < UN; ++uu) {
        const int idx = threadIdx.x + uu * NWAVES * 64;
        if (idx < total) {
            const int c = (int)(((unsigned)idx * rcp) >> 24), p = idx - c * npair, kl = kl_lo + 2 * p;
            const bf16* src = Vbase + (size_t)(gk0 + kl) * pitch + 8 * c;
            R.a[uu] = *(const u32x4*)src; R.b[uu] = *(const u32x4*)(src + pitch);
        }
    }
}
template <int UN> __device__ __forceinline__ void vt_store(const VRegs<UN>& R, LAS unsigned char* vt, int VS, int kl_lo, int kl_hi) {
    const int npair = (kl_hi - kl_lo) >> 1, total = npair * 8, rs = VS / 2;
    const unsigned rcp = (1u << 24) / (unsigned)npair + 1u;
#pragma unroll
    for (int uu = 0; uu < UN; ++uu) {
        const int idx = threadIdx.x + uu * NWAVES * 64;
        if (idx < total) {
            const int c = (int)(((unsigned)idx * rcp) >> 24), p = idx - c * npair, kl = kl_lo + 2 * p;
            LAS unsigned* dst = (LAS unsigned*)(vt + ((size_t)(8 * c) * VS + kl) * 2);
#pragma unroll
            for (int i = 0; i < 4; ++i) {
                dst[(2 * i) * rs] = (R.a[uu][i] & 0xffffu) | (R.b[uu][i] << 16);
                dst[(2 * i + 1) * rs] = (R.a[uu][i] >> 16) | (R.b[uu][i] & 0xffff0000u);
            }
        }
    }
}
template <int UN> struct KRegs { u32x4 a[UN]; };
template <int UN> __device__ __forceinline__ void kt_load(KRegs<UN>& R, const bf16* Kbase, int pitch, int gk0, int kl_lo, int kl_hi) {
    const int total = (kl_hi - kl_lo) * 8;
#pragma unroll
    for (int uu = 0; uu < UN; ++uu) {
        const int idx = threadIdx.x + uu * NWAVES * 64;
        if (idx < total) { const int kl = kl_lo + (idx >> 3), c = idx & 7; R.a[uu] = *(const u32x4*)(Kbase + (size_t)(gk0 + kl) * pitch + 8 * c); }
    }
}
template <int UN> __device__ __forceinline__ void kt_store(const KRegs<UN>& R, LAS unsigned char* kt, int kl_lo, int kl_hi) {
    const int total = (kl_hi - kl_lo) * 8;
#pragma unroll
    for (int uu = 0; uu < UN; ++uu) {
        const int idx = threadIdx.x + uu * NWAVES * 64;
        if (idx < total) { const int kl = kl_lo + (idx >> 3), c = idx & 7; *(LAS u32x4*)(kt + kl * 128 + ((c ^ ((kl >> 1) & 7)) << 4)) = R.a[uu]; }
    }
}
__device__ __forceinline__ void load_kfrag_lds(bf16x8 (&f)[4], const LAS unsigned char* kt, int kl  , int hi) {
    const LAS unsigned char* p = kt + kl * 128; const int sw = (kl >> 1) & 7;
#pragma unroll
    for (int ks = 0; ks < 4; ++ks) f[ks] = *(const LAS bf16x8*)(p + (((2 * ks + hi) ^ sw) << 4));
}
__device__ __forceinline__ void load_frag4(bf16x8 (&f)[4], const bf16* p) {
#pragma unroll
    for (int ks = 0; ks < 4; ++ks) f[ks] = *(const bf16x8*)(p + 16 * ks);
}
template <bool RAW = false>
__device__ __forceinline__ void attn_step(f32x16& s, float& m, float& l, f32x16 (&o)[2], const LAS unsigned char* vt, int VSb, int kb0, int lane) {
    float mxa = fmaxf(fmaxf(s[0], s[1]), s[2]), mxb = fmaxf(fmaxf(s[3], s[4]), s[5]);
    mxa = fmaxf(fmaxf(mxa, s[6]), s[7]); mxb = fmaxf(fmaxf(mxb, s[8]), s[9]); mxa = fmaxf(fmaxf(mxa, s[10]), s[11]); mxb = fmaxf(fmaxf(mxb, s[12]), s[13]); mxa = fmaxf(fmaxf(mxa, s[14]), s[15]);
    float mx = fmaxf(mxa, mxb);
    if constexpr (RAW) mx *= CSC;
    mx = fmaxf(mx, __shfl_xor(mx, 32));
    if (__any(mx > m + 8.0f)) {
        const float mn = fmaxf(m, mx);
        const float corr = __builtin_amdgcn_exp2f(m - mn);
        m = mn; l = l * corr;
#pragma unroll
        for (int d = 0; d < 2; ++d) o[d] = o[d] * corr;
    }
    float sum = 0.f;
#pragma unroll
    for (int i = 0; i < 16; ++i) { s[i] = __builtin_amdgcn_exp2f(RAW ? fmaf(s[i], CSC, -m) : s[i] - m); sum += s[i]; }
    sum += __shfl_xor(sum, 32);
    l = l + sum;
    bf16x8 pb[2];
#pragma unroll
    for (int st = 0; st < 2; ++st) {
        u32x4 w; w.x = pg8::cvt_pk_bf16(s[8 * st + 0], s[8 * st + 1]); w.y = pg8::cvt_pk_bf16(s[8 * st + 2], s[8 * st + 3]); w.z = pg8::cvt_pk_bf16(s[8 * st + 4], s[8 * st + 5]); w.w = pg8::cvt_pk_bf16(s[8 * st + 6], s[8 * st + 7]);
        pb[st] = __builtin_bit_cast(bf16x8, w);
    }
    const int dl = lane & 31, hi = lane >> 5;
#pragma unroll
    for (int db = 0; db < 2; ++db)
#pragma unroll
        for (int st = 0; st < 2; ++st) {
            const LAS unsigned char* p = vt + (size_t)(32 * db + dl) * VSb + (size_t)(kb0 + 16 * st + 4 * hi) * 2;
            const s16x4 a0 = *(const LAS s16x4*)p, a1 = *(const LAS s16x4*)(p + 16);
            const bf16x8 a = __builtin_shufflevector(a0, a1, 0, 1, 2, 3, 4, 5, 6, 7);
            o[db] = MFMA32(a, pb[st], o[db]);
        }
}
__device__ __forceinline__ void store_o(const f32x16 (&o)[2], float l, bf16* orow, int hi) {
    const float inv = 1.0f / l;
#pragma unroll
    for (int db = 0; db < 2; ++db)
#pragma unroll
        for (int ig = 0; ig < 4; ++ig) {
            u32x2 w; w.x = pg8::cvt_pk_bf16(o[db][4 * ig] * inv, o[db][4 * ig + 1] * inv); w.y = pg8::cvt_pk_bf16(o[db][4 * ig + 2] * inv, o[db][4 * ig + 3] * inv);
            *(u32x2*)(orow + 32 * db + 8 * ig + 4 * hi) = w;
        }
}
__device__ __forceinline__ void tile_seq(int pm, int& seq, int& jb, int& T, int& seqbase) {
    if (pm < 256) { seq = pm >> 3; jb = pm & 7; T = 2048; seqbase = seq * 2048; } else { seq = 32; jb = pm - 256; T = 16384; seqbase = MPROMPT; }
}

__device__ __forceinline__ void window_chunk(const LAS unsigned char* vt, int VSb, const LAS unsigned char* kt, const bf16x8 (&qf)[4], bf16* O, int seqbase, int T, int jb, int g, int r, int qc, float sink, int lane) {
    const int q = lane & 31, hi = lane >> 5, hq = 3 * g + r, t0 = 256 * jb + 32 * qc, t = t0 + q;
    const float slope2 = exp2f(-8.0f * (float)(hq + 1) / 12.0f) * LOG2E;
    float m = sink * LOG2E, l = 1.0f;
    f32x16 o[2];
#pragma unroll
    for (int i = 0; i < 16; ++i) { o[0][i] = 0.f; o[1][i] = 0.f; }
    const int kb_lo = (t0 / 32 - 4) > 0 ? (t0 / 32 - 4) : 0, kb_hi = (t0 / 32 + 4) < (T / 32 - 1) ? (t0 / 32 + 4) : (T / 32 - 1);
    for (int kb = kb_lo; kb <= kb_hi; ++kb) {
        const int kbl = 32 * kb - 256 * jb + 128;
        bf16x8 kf[4]; load_kfrag_lds(kf, kt, kbl + q, hi);
        f32x16 s;
#pragma unroll
        for (int i = 0; i < 16; ++i) s[i] = 0.f;
#pragma unroll
        for (int ks = 0; ks < 4; ++ks) s = MFMA32(kf[ks], qf[ks], s);
        const float base = (float)(t - 32 * kb - 4 * hi);
        if (kb != t0 / 32) {
            const float ks = (kb < t0 / 32) ? slope2 : -slope2, A = -ks * base;
#pragma unroll
            for (int i = 0; i < 16; ++i) s[i] = fmaf(s[i], CSC, fmaf((float)((i & 3) + 8 * (i >> 2)), ks, A));
        } else {
#pragma unroll
            for (int i = 0; i < 16; ++i) { const float d = base - (float)((i & 3) + 8 * (i >> 2)); s[i] = fmaf(s[i], CSC, -slope2 * fabsf(d)); }
        }
        if (kb == t0 / 32 - 4 || kb == t0 / 32 + 4) {
#pragma unroll
            for (int i = 0; i < 16; ++i) { const float d = base - (float)((i & 3) + 8 * (i >> 2)); if (fabsf(d) > 128.0f) s[i] = -INFINITY; }
        }
        attn_step(s, m, l, o, vt, VSb, kbl, lane);
    }
    store_o(o, l, O + (size_t)(seqbase + t) * 1024 + hq * 64, hi);
}
__device__ __forceinline__ void mem_chunk(const LAS unsigned char* vt, int VSb, const LAS unsigned char* kt, const bf16x8 (&qf)[4], bf16* obase, int row0, int lane) {
    const int q = lane & 31, hi = lane >> 5;
    float m = -1e30f, l = 0.f;
    f32x16 o[2];
#pragma unroll
    for (int i = 0; i < 16; ++i) { o[0][i] = 0.f; o[1][i] = 0.f; }
    for (int kb = 0; kb < 8; ++kb) {
        bf16x8 kf[4]; load_kfrag_lds(kf, kt, 32 * kb + q, hi);
        f32x16 s;
#pragma unroll
        for (int i = 0; i < 16; ++i) s[i] = 0.f;
#pragma unroll
        for (int ks = 0; ks < 4; ++ks) s = MFMA32(kf[ks], qf[ks], s);
        attn_step<true>(s, m, l, o, vt, VSb, 32 * kb, lane);
    }
    store_o(o, l, obase + (size_t)(row0 + q) * 1024, hi);
}
__device__ __forceinline__ void na_chunk(const LAS unsigned char* vt, int VSb, const LAS float* rpbL, const bf16* kptr  , bf16* optr  ,
                                         const bf16x8 (&qf)[4], bf16x8 (&kf)[4], bf16x8 (&kf1)[4], int row_q, int c, int col0, int r0q, int kr_lo, int kr_hi, int klo, int lane) {
    const int hi = lane >> 5;
    int c0 = c - 8; c0 = c0 < 0 ? 0 : c0; c0 = c0 > 48 ? 48 : c0;
    float m = -1e30f, l = 0.f;
    f32x16 o[2];
#pragma unroll
    for (int i = 0; i < 16; ++i) { o[0][i] = 0.f; o[1][i] = 0.f; }
    int dcc[16];
#pragma unroll
    for (int ii = 0; ii < 16; ++ii) { const int kc = col0 + crow(ii, hi); dcc[ii] = ((unsigned)(kc - c0) < 16u) ? (kc - c + 15) : 31; }
    bf16x8 kn[4];
#define NA_BLOCK(KF) do { \
        f32x16 s; \
        _Pragma("unroll") for (int ii = 0; ii < 16; ++ii) s[ii] = 0.f; \
        _Pragma("unroll") for (int ks = 0; ks < 4; ++ks) s = MFMA32(KF[ks], qf[ks], s); \
        const int br = ((unsigned)(kr - r0q) < 8u) ? (kr - row_q + 7) : 15;     \
        const LAS float* brow = rpbL + br * 32; \
        _Pragma("unroll") for (int ii = 0; ii < 16; ++ii) s[ii] = fmaf(s[ii], CSC, brow[dcc[ii]]); \
        attn_step(s, m, l, o, vt, VSb, (kr - klo) * 64 + col0, lane); } while (0)
#define NA_LOAD(KF) do { if (kr + 2 <= kr_hi) load_frag4(KF, kptr + (size_t)(kr + 2 - kr_lo) * 64 * 2560); } while (0)
    for (int kr = kr_lo;;) {
        NA_LOAD(kn);  NA_BLOCK(kf);  if (++kr > kr_hi) break;
        NA_LOAD(kf);  NA_BLOCK(kf1); if (++kr > kr_hi) break;
        NA_LOAD(kf1); NA_BLOCK(kn);  if (++kr > kr_hi) break;
    }
#undef NA_BLOCK
#undef NA_LOAD
    store_o(o, l, optr, hi);
}

#define LDS_BARRIER() do { asm volatile("s_waitcnt lgkmcnt(0)" ::: "memory"); __builtin_amdgcn_s_barrier(); asm volatile("" ::: "memory"); } while (0)
constexpr int MEM_KT_OFF = 34816;
__device__ __forceinline__ void mem_units(LAS unsigned char* lds, const bf16* proj, int qpitch, int qcol, const bf16* mkv, int layer, bf16* O, int wave, int lane, int vcu) {
    const int N = NTILE * 4, G = gridDim.x;
    VRegs<2> VR; KRegs<4> KR; bf16x8 qn[4];
    const int ql = (lane & 31), qh = 8 * (lane >> 5);
    if (vcu < N) { const int hm = vcu / NTILE, pm = vcu - hm * NTILE; int seq, jb, T, seqbase; tile_seq(pm, seq, jb, T, seqbase);
        vt_load<2>(VR, mkv + layer * 512 + 256 + hm * 64, 1024, seq * 256, 0, 256); kt_load<4>(KR, mkv + layer * 512 + hm * 64, 1024, seq * 256, 0, 256);
        load_frag4(qn, proj + qcol + hm * 64 + (size_t)(pm * 256 + 32 * wave + ql) * qpitch + qh); }
    for (int u = vcu; u < N; u += G) {
        const int hm = u / NTILE, pm = u - hm * NTILE; int seq, jb, T, seqbase; tile_seq(pm, seq, jb, T, seqbase);
        bf16x8 qf[4];
#pragma unroll
        for (int ks = 0; ks < 4; ++ks) qf[ks] = qn[ks];
        LDS_BARRIER();
        vt_store<2>(VR, lds, 260, 0, 256); kt_store<4>(KR, lds + MEM_KT_OFF, 0, 256);
        LDS_BARRIER();
        const int un = u + G;
        if (un < N) { const int hm2 = un / NTILE, pm2 = un - hm2 * NTILE; int seq2, jb2, T2, sb2; tile_seq(pm2, seq2, jb2, T2, sb2);
            vt_load<2>(VR, mkv + layer * 512 + 256 + hm2 * 64, 1024, seq2 * 256, 0, 256); kt_load<4>(KR, mkv + layer * 512 + hm2 * 64, 1024, seq2 * 256, 0, 256);
            load_frag4(qn, proj + qcol + hm2 * 64 + (size_t)(pm2 * 256 + 32 * wave + ql) * qpitch + qh); }
        mem_chunk(lds, 260 * 2, lds + MEM_KT_OFF, qf, O + 768 + hm * 64, pm * 256 + 32 * wave, lane);
    }
}

#define LOAD_ARGS() \
    const CAS Args* ap_ = (const CAS Args*)__builtin_amdgcn_kernarg_segment_ptr(); asm volatile("" : "+s"(ap_)); \
    unsigned char* ws = ap_->ws; float* out = ap_->out; (void)out; \
    bf16* WinA = (bf16*)(ws + WS_WINA); bf16* WinB = (bf16*)(ws + WS_WINB); bf16* Wmkv = (bf16*)(ws + WS_WMKV); bf16* Wo = (bf16*)(ws + WS_WO); bf16* Wgu = (bf16*)(ws + WS_WGU); bf16* Wd = (bf16*)(ws + WS_WD); \
    float* SS = (float*)(ws + WS_SS); float* SSM = (float*)(ws + WS_SSM); bf16* MB = (bf16*)(ws + WS_MB); bf16* MKV = (bf16*)(ws + WS_MKV); float* SB = (float*)(ws + WS_SB); \
    bf16* XB = (bf16*)(ws + WS_XB); bf16* PROJ = (bf16*)(ws + WS_PROJ); bf16* OB = (bf16*)(ws + WS_O); bf16* ACT = (bf16*)(ws + WS_ACT); \
    (void)WinA; (void)WinB; (void)Wmkv; (void)Wo; (void)Wgu; (void)Wd; (void)SS; (void)SSM; (void)MB; (void)MKV; (void)SB; (void)XB; (void)PROJ; (void)OB; (void)ACT;
#define ARG(k) (ap_->in[k])
template <int layer>
__device__ __forceinline__ void layer_phases(LAS unsigned char* lds, LAS float* ldsx, const int lo, const int hi_ph, const int G, const int bx) {
    int tid = threadIdx.x; asm volatile("" : "+v"(tid));
    const int lane = tid & 63, wave = __builtin_amdgcn_readfirstlane(tid >> 6);
#define IN(k) (lo <= (k) && (k) < hi_ph)
#define SEAM(k) do { if (IN(k) && IN((k) + 1)) { if ((k) == 0) cg::this_grid().sync(); else { const CAS Args* apb_ = (const CAS Args*)__builtin_amdgcn_kernarg_segment_ptr(); asm volatile("" : "+s"(apb_)); xcd_barrier((unsigned*)(apb_->ws + WS_CTL), (volatile LAS unsigned*)(lds + MISC_OFF)); } } } while (0)
        const int pb = 1 + 6 * layer;
        const int NP = layer == 0 ? 1536 : 2560;
        if (IN(pb)) {
            LOAD_ARGS();
            for (int rep = 0; rep < NREP(1); ++rep)
            { pg8::Gemm g{XB, layer == 0 ? WinA : WinB, MTOK, NP, D, 0}; pg8::StaticOrder S; S.init(MTOK, NP, G, bx);
              pg8::EpiScaleBf16 E{PROJ, NP, SS};
              pg8::gemm_phase<pg8::EpiScaleBf16, pg8::StaticOrder>(lds, g, S, E); }
            { pg8::Gemm g{MB, Wmkv + (size_t)layer * 512 * 1024, MMEM, 512, D, 0}; pg8::StaticOrder S; S.init(MMEM, 512, G, (bx + G / 2) % G);
              pg8::EpiScaleBf16 E{MKV + layer * 512, 1024, SSM};
              pg8::gemm_phase<pg8::EpiScaleBf16, pg8::StaticOrder>(lds, g, S, E); }
        }
        SEAM(pb);
        if (IN(pb + 1)) {
            LOAD_ARGS();
            const float* sink_a = ARG(7); const float* rpb_b = ARG(9);
            const int vcu = (G % 8 == 0) ? (bx % 8) * (G / 8) + bx / 8 : bx;
            if (layer == 0) {
                {
                    const int N = NTILE * 4;
                    VRegs<4> VR; KRegs<8> KR; bf16x8 qn[4]; LAS unsigned char* ktw = lds + 69632;
                    if (vcu < N) { const int g = vcu / NTILE, pm = vcu - g * NTILE; int seq, jb, T, seqbase; tile_seq(pm, seq, jb, T, seqbase);
                        const int kl_lo = (jb == 0) ? 128 : 0; int kl_hi = T - 256 * jb + 128; kl_hi = kl_hi > 512 ? 512 : kl_hi;
                        vt_load<4>(VR, PROJ + 1024 + g * 64, 1536, seqbase + 256 * jb - 128, kl_lo, kl_hi); kt_load<8>(KR, PROJ + 768 + g * 64, 1536, seqbase + 256 * jb - 128, kl_lo, kl_hi);
                        { const int c0_ = 3 * wave, r0_ = c0_ >> 3, qc0_ = c0_ & 7; load_frag4(qn, PROJ + (size_t)(seqbase + 256 * jb + 32 * qc0_ + (lane & 31)) * 1536 + (3 * g + r0_) * 64 + 8 * (lane >> 5)); } }
                    for (int u = vcu; u < N; u += G) {
                        const int g = u / NTILE, pm = u - g * NTILE; int seq, jb, T, seqbase; tile_seq(pm, seq, jb, T, seqbase);
                        const int kl_lo = (jb == 0) ? 128 : 0; int kl_hi = T - 256 * jb + 128; kl_hi = kl_hi > 512 ? 512 : kl_hi;
                        LDS_BARRIER();
                        vt_store<4>(VR, lds, 516, kl_lo, kl_hi); kt_store<8>(KR, ktw, kl_lo, kl_hi);
                        LDS_BARRIER();
                        const int un = u + G;
                        if (un < N) { const int g2 = un / NTILE, pm2 = un - g2 * NTILE; int seq2, jb2, T2, sb2; tile_seq(pm2, seq2, jb2, T2, sb2);
                            const int kl_lo2 = (jb2 == 0) ? 128 : 0; int kl_hi2 = T2 - 256 * jb2 + 128; kl_hi2 = kl_hi2 > 512 ? 512 : kl_hi2;
                            vt_load<4>(VR, PROJ + 1024 + g2 * 64, 1536, sb2 + 256 * jb2 - 128, kl_lo2, kl_hi2); kt_load<8>(KR, PROJ + 768 + g2 * 64, 1536, sb2 + 256 * jb2 - 128, kl_lo2, kl_hi2); }
#pragma unroll 1
                        for (int i = 0; i < 3; ++i) { const int cidx = 3 * wave + i, r = cidx >> 3, qc = cidx & 7;
                            bf16x8 qf[4];
#pragma unroll
                            for (int ks = 0; ks < 4; ++ks) qf[ks] = qn[ks];
                            {
                                int u2 = u, i2 = i + 1; if (i2 == 3) { i2 = 0; u2 = u + G; }
                                if (u2 < N) { const int g2 = u2 / NTILE, pm2 = u2 - g2 * NTILE; int seq2, jb2, T2, sb2; tile_seq(pm2, seq2, jb2, T2, sb2);
                                    const int c2 = 3 * wave + i2, r2 = c2 >> 3, qc2 = c2 & 7;
                                    load_frag4(qn, PROJ + (size_t)(sb2 + 256 * jb2 + 32 * qc2 + (lane & 31)) * 1536 + (3 * g2 + r2) * 64 + 8 * (lane >> 5)); }
                            }
                            window_chunk(lds, 516 * 2, ktw, qf, OB, seqbase, T, jb, g, r, qc, sink_a[3 * g + r], lane); }
                    }
                }
                mem_units(lds, PROJ, 1536, 1280, MKV, 0, OB, wave, lane, vcu);
            } else {
                LAS float* rpbL = (LAS float*)(lds + 98304);
                {
                    const int N = NTILE * 12;
                    VRegs<6> VR; float rpbv = 0.f; bf16x8 qn[4], kn0[4];
#define NA_QK(uu_) { NA_DESC(uu_, hq_, jbq_, sbq_, rowsq_, kloq_, khiq_); (void)kloq_; (void)khiq_; const int rpq_ = wave >> 2, aq_ = wave & 3, qq_ = lane & 31, hiq_ = lane >> 5; \
                        const int rAq_ = 4 * jbq_ + 2 * rpq_, rowq_ = rAq_ + (qq_ >> 4), cq_ = 16 * aq_ + (qq_ & 15); int col0q_ = 16 * aq_ - 8; col0q_ = col0q_ < 0 ? 0 : col0q_; col0q_ = col0q_ > 32 ? 32 : col0q_; \
                        int krq_ = rAq_ - 4; krq_ = krq_ < 0 ? 0 : krq_; krq_ = krq_ > rowsq_ - 8 ? rowsq_ - 8 : krq_; \
                        const bf16* kpq_ = PROJ + 768 + hq_ * 64 + 8 * hiq_ + (size_t)(sbq_ + krq_ * 64 + col0q_ + qq_) * 2560; \
                        load_frag4(qn, PROJ + (size_t)(sbq_ + rowq_ * 64 + cq_) * 2560 + hq_ * 64 + 8 * hiq_); load_frag4(kn0, kpq_); }
#define NA_DESC(uu_, h_, jb_, sb_, rows_, klo_, khi_) const int h_ = (uu_) / NTILE; int jb_, sb_, rows_, klo_, khi_; { const int pm_ = (uu_) - h_ * NTILE; int seq_, T_; tile_seq(pm_, seq_, jb_, T_, sb_); rows_ = T_ / 64; \
                        klo_ = 4 * jb_ - 4; klo_ = klo_ < 0 ? 0 : klo_; klo_ = klo_ > rows_ - 8 ? rows_ - 8 : klo_; khi_ = 4 * jb_ + 3 - 4; khi_ = khi_ < 0 ? 0 : khi_; khi_ = khi_ > rows_ - 8 ? rows_ - 8 : khi_; khi_ += 8; }
                    if (vcu < N) { NA_DESC(vcu, h0, jb0, sb0, rows0, klo0, khi0);
                        vt_load<6>(VR, PROJ + 1536 + h0 * 64, 2560, sb0 + klo0 * 64, 0, (khi0 - klo0) * 64); { const int tr = tid >> 5, tc = tid & 31; rpbv = (tr < 15 && tc < 31) ? rpb_b[h0 * 465 + tr * 31 + tc] * LOG2E : -INFINITY; } NA_QK(vcu); }
                    for (int u = vcu; u < N; u += G) {
                        NA_DESC(u, h, jb, seqbase, rows, klo, khi);
                        const int rp = wave >> 2, a = wave & 3, q = lane & 31, hi = lane >> 5;
                        const int rA = 4 * jb + 2 * rp, row_q = rA + (q >> 4), c = 16 * a + (q & 15);
                        int col0 = 16 * a - 8; col0 = col0 < 0 ? 0 : col0; col0 = col0 > 32 ? 32 : col0;
                        int r0q = row_q - 4; r0q = r0q < 0 ? 0 : r0q; r0q = r0q > rows - 8 ? rows - 8 : r0q;
                        int kr_lo = rA - 4; kr_lo = kr_lo < 0 ? 0 : kr_lo; kr_lo = kr_lo > rows - 8 ? rows - 8 : kr_lo;
                        int kr_hi = rA + 1 - 4; kr_hi = kr_hi < 0 ? 0 : kr_hi; kr_hi = kr_hi > rows - 8 ? rows - 8 : kr_hi; kr_hi += 7;
                        const bf16* kptr = PROJ + 768 + h * 64 + 8 * hi + (size_t)(seqbase + kr_lo * 64 + col0 + q) * 2560;
                        bf16x8 qf[4], kf[4], kf1[4];
#pragma unroll
                        for (int ks = 0; ks < 4; ++ks) { qf[ks] = qn[ks]; kf[ks] = kn0[ks]; }
                        load_frag4(kf1, kptr + (size_t)64 * 2560);
                        LDS_BARRIER();
                        vt_store<6>(VR, lds, 708, 0, (khi - klo) * 64);
                        rpbL[tid] = rpbv;
                        LDS_BARRIER();
                        const int un = u + G;
                        if (un < N) { NA_DESC(un, h2, jb2, sb2, rows2, klo2, khi2);
                            vt_load<6>(VR, PROJ + 1536 + h2 * 64, 2560, sb2 + klo2 * 64, 0, (khi2 - klo2) * 64); { const int tr = tid >> 5, tc = tid & 31; rpbv = (tr < 15 && tc < 31) ? rpb_b[h2 * 465 + tr * 31 + tc] * LOG2E : -INFINITY; } NA_QK(un); }
                        na_chunk(lds, 708 * 2, rpbL, kptr, OB + (size_t)(seqbase + row_q * 64 + c) * 1024 + h * 64, qf, kf, kf1, row_q, c, col0, r0q, kr_lo, kr_hi, klo, lane);
                    }
#undef NA_QK
#undef NA_DESC
                }
                mem_units(lds, PROJ, 2560, 2304, MKV, 1, OB, wave, lane, vcu);
            }
        }
        SEAM(pb + 1);
        if (IN(pb + 2)) {
            LOAD_ARGS();
            pg8::Gemm g{OB, Wo + (size_t)layer * 1024 * 1024, MTOK, D, D, 0}; pg8::StaticOrder S; S.init(MTOK, D, G, bx);
            pg8::EpiResid E{XB, SS, ldsx};
            pg8::gemm_phase<pg8::EpiResid, pg8::StaticOrder>(lds, g, S, E);
        }
        SEAM(pb + 2);
        if (IN(pb + 3)) {
            LOAD_ARGS();
            const float* conv_w = ARG(15); const float* conv_b = ARG(16);
            pg8::Gemm g{XB, Wgu + (size_t)layer * 5632 * 1024, MTOK, 5632, D, 0}; pg8::StaticOrder S; S.init(MTOK, 5632, G, bx);
            pg8::EpiGateUp E{ACT, SS, conv_w + (size_t)layer * 3 * FF, conv_b + (size_t)layer * FF, SB, ldsx};
            if (tid < 128) { ldsx[tid] = 0.f; ldsx[(17 + 16) * 128 + tid] = 0.f; }
            __syncthreads();
            for (int rep = 0; rep < NREP(6); ++rep) pg8::gemm_phase<pg8::EpiGateUp, pg8::StaticOrder>(lds, g, S, E);
            if constexpr (layer == 0) {
                if (bx >= G / 2) {
                    const float* inp[19];
#pragma unroll
                    for (int i_ = 0; i_ < 19; ++i_) inp[i_] = ARG(i_);
                    convert_layer_weights<1>(inp, ws, (LAS float*)(lds + wave * 16384), (bx - G / 2) * NWAVES + wave, (G - G / 2) * NWAVES, lane);
                }
            }
        }
        SEAM(pb + 3);
        if (IN(pb + 4)) {
            LOAD_ARGS();
            const float* conv_w = ARG(15);
            const float* cw = conv_w + (size_t)layer * 3 * FF;
            for (int idx = bx * (NWAVES * 64) + tid; idx < NTILE * 2 * FF; idx += G * NWAVES * 64) {
                const int col = idx % FF, pw = idx / FF, pm = pw >> 1, which = pw & 1;
                const float part = SB[(size_t)(pw * 3 + 1) * FF + col], uu = SB[(size_t)(pw * 3 + 2) * FF + col];
                const bool seq_start = (pm < 256) ? ((pm & 7) == 0) : (pm == 256);
                const bool seq_end = (pm < 256) ? ((pm & 7) == 7) : (pm == NTILE - 1);
                float c = part;
                if (which == 0) { if (!seq_start) c += cw[col] * SB[(size_t)(((pm - 1) * 2 + 1) * 3) * FF + col]; }
                else { if (!seq_end) c += cw[2 * FF + col] * SB[(size_t)(((pm + 1) * 2) * 3) * FF + col]; }
                const float sg = 1.0f / (1.0f + __builtin_amdgcn_exp2f(-LOG2E * c));
                ACT[pg8::ilv_off(pm * 256 + (which ? 255 : 0), col, FF)] = (bf16)f2bf(c * sg * uu);
            }
        }
        SEAM(pb + 4);
        if (IN(pb + 5)) {
            LOAD_ARGS();
            pg8::Gemm g{ACT, Wd + (size_t)layer * 1024 * FF, MTOK, D, FF, 1}; pg8::StaticOrder S; S.init(MTOK, D, G, bx);
            if constexpr (layer == 0) {
                pg8::EpiResid E{XB, SS, ldsx};
                pg8::gemm_phase<pg8::EpiResid, pg8::StaticOrder>(lds, g, S, E);
            } else {
                pg8::EpiFinal E{XB, out, ARG(18), (float*)(ws + WS_XS), (unsigned*)(ws + WS_CTL) + CW_PANEL, ldsx};
                pg8::gemm_phase<pg8::EpiFinal, pg8::StaticOrder>(lds, g, S, E);
            }
        }
        if constexpr (layer == 0) { SEAM(pb + 5); }
#undef IN
#undef SEAM
}

__global__ void __launch_bounds__(NWAVES * 64, 2) mega_fwd(Args args) {
    extern __shared__ __attribute__((aligned(16))) unsigned char lds_raw[];
    LAS unsigned char* lds = (LAS unsigned char*)lds_raw;
    const int G = gridDim.x, bx = blockIdx.x;
    if (threadIdx.x < 16) ((volatile LAS unsigned*)(lds + MISC_OFF))[threadIdx.x] = 0u;
    __syncthreads();
    { const CAS Args* apc_ = (const CAS Args*)__builtin_amdgcn_kernarg_segment_ptr(); if (apc_->ph_hi - apc_->ph_lo > 1 && threadIdx.x == 0) (void)xb_add((unsigned*)(apc_->ws + WS_CTL) + XB_XCNT(xb_xcc_id()), 1u); }
#define PHASE_TID() int tid = threadIdx.x; asm volatile("" : "+v"(tid)); const int lane = tid & 63, wave = __builtin_amdgcn_readfirstlane(tid >> 6); (void)lane; (void)wave;
    LAS float* ldsx = (LAS float*)(lds + LDS_X_OFF);

    int lo, hi_ph; { const CAS Args* ap0 = (const CAS Args*)__builtin_amdgcn_kernarg_segment_ptr(); lo = ap0->ph_lo; hi_ph = ap0->ph_hi; }
#define IN(k) (lo <= (k) && (k) < hi_ph)
#define SEAM(k) do { if (IN(k) && IN((k) + 1)) { if ((k) == 0) cg::this_grid().sync(); else { const CAS Args* apb_ = (const CAS Args*)__builtin_amdgcn_kernarg_segment_ptr(); asm volatile("" : "+s"(apb_)); xcd_barrier((unsigned*)(apb_->ws + WS_CTL), (volatile LAS unsigned*)(lds + MISC_OFF)); } } } while (0)

    if (IN(0)) {
        LOAD_ARGS(); PHASE_TID();
        const float* x_prompt = ARG(0); const float* x_sample = ARG(1); const float* mem_prompt = ARG(2); const float* mem_sample = ARG(3); const float* g_mix = ARG(4); const float* g_mem = ARG(5);
        const float* w_in_a = ARG(6); const float* w_in_b = ARG(8); const float* w_mem_kv = ARG(10); const float* w_o = ARG(11); const float* g_ffn = ARG(12); const float* w_gate = ARG(13); const float* w_up = ARG(14); const float* w_down = ARG(17);
        LAS float* scr = (LAS float*)(lds + wave * 16384);
        const int gw = bx * NWAVES + wave, NGW = G * NWAVES;
        for (int rep = 0; rep < NREP(0); ++rep) {
        { const float* inp[19];
#pragma unroll
          for (int i_ = 0; i_ < 19; ++i_) inp[i_] = ARG(i_);
          convert_layer_weights<0>(inp, ws, scr, gw, NGW, lane); }
        for (int m = gw; m < MTOK + MMEM; m += NGW) {
            if (m < MTOK) { const float* xr = m < MPROMPT ? x_prompt + (size_t)m * D : x_sample + (size_t)(m - MPROMPT) * D; row_to_bf16(xr, XB + (size_t)m * D, SS + (size_t)m * 4, lane); }
            else { const int mm = m - MTOK; const float* xr = mm < 8192 ? mem_prompt + (size_t)mm * D : mem_sample + (size_t)(mm - 8192) * D; row_to_bf16(xr, MB + (size_t)mm * D, SSM + (size_t)mm * 4, lane); }
        }
        }
    }
    SEAM(0);

    layer_phases<0>(lds, ldsx, lo, hi_ph, G, bx);
    layer_phases<1>(lds, ldsx, lo, hi_ph, G, bx);
#undef IN
#undef SEAM
}

constexpr int N_PHASES = 13;
extern "C" void kernel_launch(void* const* d_in, const int* in_sizes, int n_in, void* d_out, int out_size, void* d_ws, size_t ws_size, hipStream_t stream) {
    static int grid = 0;
    if (grid == 0) {
        if (n_in != 19 || out_size != MTOK * D || ws_size < WS_END) { fprintf(stderr, "kernel_launch: unexpected shapes n_in %d out %d ws %zu\n", n_in, out_size, ws_size); grid = -1; return; }
        int dev = 0, cus = 0, per_cu = 0;
        if (hipGetDevice(&dev) != hipSuccess || hipDeviceGetAttribute(&cus, hipDeviceAttributeMultiprocessorCount, dev) != hipSuccess) { grid = -1; return; }
        if (hipFuncSetAttribute((const void*)mega_fwd, hipFuncAttributeMaxDynamicSharedMemorySize, LDS_BYTES) != hipSuccess) { fprintf(stderr, "kernel_launch: hipFuncSetAttribute failed\n"); grid = -1; return; }
        if (hipOccupancyMaxActiveBlocksPerMultiprocessor(&per_cu, (const void*)mega_fwd, NWAVES * 64, LDS_BYTES) != hipSuccess || per_cu < 1) { fprintf(stderr, "kernel_launch: occupancy query says %d\n", per_cu); per_cu = 1; }
        (void)hipGetLastError();
        grid = cus * 1;
    }
    if (grid < 0) return;
    if (hipMemsetAsync((char*)d_ws + WS_CTL, 0, CTL_ZERO_BYTES, stream) != hipSuccess) { fprintf(stderr, "kernel_launch: memset failed\n"); return; }
    Args a{};
    for (int i = 0; i < 19; ++i) a.in[i] = (const float*)d_in[i];
    a.out = (float*)d_out; a.ws = (unsigned char*)d_ws;
#if MK_ONE_LAUNCH
    a.ph_lo = 0; a.ph_hi = N_PHASES;
    void* kargs[] = {&a};
    hipError_t e = hipLaunchCooperativeKernel((const void*)mega_fwd, dim3(grid), dim3(NWAVES * 64), kargs, LDS_BYTES, stream);
    if (e != hipSuccess) fprintf(stderr, "cooperative launch failed: %s (grid %d)\n", hipGetErrorString(e), grid);
#else
    for (int p = 0; p < N_PHASES; ++p) { a.ph_lo = p; a.ph_hi = p + 1; hipLaunchKernelGGL(mega_fwd, dim3(grid), dim3(NWAVES * 64), LDS_BYTES, stream, a); }
#endif
}
```
